# Optimizing an MI355X kernel written in HIP

```python
import math
import jax, jax.numpy as jnp
from jax import lax
import numpy as np

D_MODEL = 2048
BATCH = 16
SEQ = 2048
DEPTH = 1

LRU_W = D_MODEL // 2
LRU_BLOCKS = 8
LRU_BW = LRU_W // LRU_BLOCKS
CONV_W = 4
LRU_C = 8.0
ATT_DV = 128
ATT_DQK = ATT_DV // 2
ATT_HEADS = (D_MODEL - LRU_W) // ATT_DV
ATT_QK = 2 * ATT_HEADS * ATT_DQK
ATT_V = ATT_HEADS * ATT_DV
MIX_W = LRU_W + ATT_V
IN_W = 2 * LRU_W + 2 * ATT_QK + ATT_V
Q_BLOCK = 128
REL_BUCKETS = 32
REL_MAX_DIST = 128
FFN_HIDDEN = int(math.ceil(8 * D_MODEL / 3 / 256)) * 256
PLE_DIM = 256
LN_EPS = 1e-5
ALPHA = (2 * DEPTH) ** 0.25
BETA = (8 * DEPTH) ** -0.25

kernel_name = "hymba_rglru_diffattn_deepnorm_ple"


def layer_norm(x, g, b):
    xf = x.astype(jnp.float32)
    mu = jnp.mean(xf, axis=-1, keepdims=True)
    xc = xf - mu
    var = jnp.mean(xc * xc, axis=-1, keepdims=True)
    return (xc * lax.rsqrt(var + LN_EPS) * g.astype(jnp.float32) + b.astype(jnp.float32)).astype(x.dtype)


def rms_norm(x, g):
    xf = x.astype(jnp.float32)
    y = xf * lax.rsqrt(jnp.mean(xf * xf, axis=-1, keepdims=True) + LN_EPS)
    return y * g.astype(jnp.float32)


def t5_causal_bucket(rel):
    n = jnp.maximum(-rel, 0)
    max_exact = REL_BUCKETS // 2
    nf = jnp.maximum(n, 1).astype(jnp.float32)
    large = max_exact + (jnp.log(nf / max_exact) / math.log(REL_MAX_DIST / max_exact)
                         * (REL_BUCKETS - max_exact)).astype(jnp.int32)
    large = jnp.minimum(large, REL_BUCKETS - 1)
    return jnp.where(n < max_exact, n, large)


def causal_depthwise_conv(x, w, b):
    S = x.shape[1]
    xp = jnp.pad(x, ((0, 0), (CONV_W - 1, 0), (0, 0)))
    y = b
    for t in range(CONV_W):
        y = y + xp[:, t:t + S, :] * w[t]
    return y


def rg_lru(x, w_a, b_a, w_x, b_x, lam):
    B, S, W = x.shape
    xf = x.astype(jnp.float32)
    xb = xf.reshape(B, S, LRU_BLOCKS, LRU_BW)
    gate_x = jax.nn.sigmoid(jnp.einsum('bsnc,ncd->bsnd', xb, w_x.astype(jnp.float32)) + b_x.astype(jnp.float32)).reshape(B, S, W)
    gate_a = jax.nn.sigmoid(jnp.einsum('bsnc,ncd->bsnd', xb, w_a.astype(jnp.float32)) + b_a.astype(jnp.float32)).reshape(B, S, W)
    log_a = -LRU_C * gate_a * jax.nn.softplus(-lam.astype(jnp.float32))
    a = jnp.exp(log_a)
    mult = jnp.sqrt(-jnp.expm1(2.0 * log_a))
    u = mult * (gate_x * xf)

    def step(h, au):
        a_t, u_t = au
        h = a_t * h + u_t
        return h, h

    h0 = jnp.zeros((B, W), jnp.float32)
    _, hs = lax.scan(step, h0, (jnp.swapaxes(a, 0, 1), jnp.swapaxes(u, 0, 1)))
    return jnp.swapaxes(hs, 0, 1).astype(x.dtype)


def diff_attention(q, k, v, lq1, lk1, lq2, lk2, subln_g, rel_bias, lam_init):
    B, S, _ = q.shape
    H = ATT_HEADS
    q = q.reshape(B, S, 2 * H, ATT_DQK) * (ATT_DQK ** -0.5)
    k = k.reshape(B, S, 2 * H, ATT_DQK)
    v = v.reshape(B, S, H, ATT_DV)
    lam = (jnp.exp(jnp.sum(lq1.astype(jnp.float32) * lk1.astype(jnp.float32)))
           - jnp.exp(jnp.sum(lq2.astype(jnp.float32) * lk2.astype(jnp.float32))) + lam_init)
    nb = S // Q_BLOCK
    qb = jnp.swapaxes(q.reshape(B, nb, Q_BLOCK, 2 * H, ATT_DQK), 0, 1)
    starts = jnp.arange(nb, dtype=jnp.int32) * Q_BLOCK
    kpos = jnp.arange(S, dtype=jnp.int32)
    table = rel_bias.astype(jnp.float32)

    def one_block(args):
        q_blk, start = args
        qpos = start + jnp.arange(Q_BLOCK, dtype=jnp.int32)
        rel = kpos[None, :] - qpos[:, None]
        bias = jnp.transpose(table[t5_causal_bucket(rel)], (2, 0, 1))
        s = jnp.einsum('bqhd,bkhd->bhqk', q_blk, k).astype(jnp.float32)
        s = s.reshape(B, H, 2, Q_BLOCK, S) + bias[None, :, None]
        s = jnp.where((rel <= 0)[None, None, None], s, -jnp.inf)
        pr = jax.nn.softmax(s, axis=-1)
        attn = pr[:, :, 0] - lam * pr[:, :, 1]
        return jnp.einsum('bhqk,bkhd->bqhd', attn.astype(v.dtype), v)

    out = lax.map(one_block, (qb, starts))
    out = jnp.swapaxes(out, 0, 1).reshape(B, S, H, ATT_DV)
    out = rms_norm(out, subln_g) * (1.0 - lam_init)
    return out.reshape(B, S, ATT_V).astype(q.dtype)


def hybrid_mixer(h, w_in, conv_w, conv_b, lru_wa, lru_ba, lru_wx, lru_bx, lru_lambda,
                 lq1, lk1, lq2, lk2, subln_g, rel_bias, w_out, lam_init):
    proj = jnp.einsum('bsd,de->bse', h, w_in)
    xr, yg, q, k, v = jnp.split(
        proj, [LRU_W, 2 * LRU_W, 2 * LRU_W + ATT_QK, 2 * LRU_W + 2 * ATT_QK], axis=-1)
    rec = rg_lru(causal_depthwise_conv(xr, conv_w, conv_b), lru_wa, lru_ba, lru_wx, lru_bx, lru_lambda)
    rec = rec * jax.nn.gelu(yg, approximate=True)
    att = diff_attention(q, k, v, lq1, lk1, lq2, lk2, subln_g, rel_bias, lam_init)
    merged = jnp.concatenate([rec, att], axis=-1)
    return jnp.einsum('bse,ed->bsd', merged, w_out)


def swiglu(h, w_gate, w_up, w_down):
    g = jnp.einsum('bsd,df->bsf', h, w_gate)
    u = jnp.einsum('bsd,df->bsf', h, w_up)
    return jnp.einsum('bsf,fd->bsd', jax.nn.silu(g) * u, w_down)


def setup_inputs(seed: int = 0) -> dict:
    key = jax.random.key(seed)
    ks = jax.random.split(key, 32)
    L, D = DEPTH, D_MODEL

    def nrm(k, shape, scale):
        return jax.random.normal(k, shape, jnp.float32) * scale

    x = nrm(ks[0], (BATCH, SEQ, D), 1.0)
    p = nrm(ks[1], (L, BATCH, SEQ, PLE_DIM), 1.0)
    col_scale = jnp.concatenate([jnp.ones((IN_W - ATT_V,), jnp.float32),
                                 jnp.full((ATT_V,), BETA, jnp.float32)])
    w_in = nrm(ks[2], (L, D, IN_W), D ** -0.5) * col_scale
    conv_w = nrm(ks[3], (L, CONV_W, LRU_W), CONV_W ** -0.5)
    conv_b = nrm(ks[4], (L, LRU_W), 0.01)
    lru_wa = nrm(ks[5], (L, LRU_BLOCKS, LRU_BW, LRU_BW), LRU_BW ** -0.5)
    lru_ba = nrm(ks[6], (L, LRU_BLOCKS, LRU_BW), 0.01)
    lru_wx = nrm(ks[7], (L, LRU_BLOCKS, LRU_BW, LRU_BW), LRU_BW ** -0.5)
    lru_bx = nrm(ks[8], (L, LRU_BLOCKS, LRU_BW), 0.01)
    u = jax.random.uniform(ks[9], (L, LRU_W), jnp.float32, 0.9, 0.999)
    s = u ** (1.0 / LRU_C)
    lru_lambda = jnp.log(s) - jnp.log1p(-s)
    diff_lq1 = nrm(ks[10], (L, ATT_DQK), 0.1)
    diff_lk1 = nrm(ks[11], (L, ATT_DQK), 0.1)
    diff_lq2 = nrm(ks[12], (L, ATT_DQK), 0.1)
    diff_lk2 = nrm(ks[13], (L, ATT_DQK), 0.1)
    diff_subln_g = 1.0 + nrm(ks[14], (L, ATT_DV), 0.02)
    rel_bias = nrm(ks[15], (REL_BUCKETS, ATT_HEADS), 0.5)
    w_out = nrm(ks[16], (L, MIX_W, D), MIX_W ** -0.5 * BETA)
    ln1_g = 1.0 + nrm(ks[17], (L, D), 0.02)
    ln1_b = nrm(ks[18], (L, D), 0.01)
    w_ffn_gate = nrm(ks[19], (L, D, FFN_HIDDEN), D ** -0.5 * BETA)
    w_ffn_up = nrm(ks[20], (L, D, FFN_HIDDEN), D ** -0.5 * BETA)
    w_ffn_down = nrm(ks[21], (L, FFN_HIDDEN, D), FFN_HIDDEN ** -0.5 * BETA)
    ln2_g = 1.0 + nrm(ks[22], (L, D), 0.02)
    ln2_b = nrm(ks[23], (L, D), 0.01)
    w_ple_gate = nrm(ks[24], (L, D, D), D ** -0.5)
    b_ple_gate = nrm(ks[25], (L, D), 0.01)
    w_ple_proj = nrm(ks[26], (L, PLE_DIM, D), PLE_DIM ** -0.5 * BETA)
    ln3_g = 1.0 + nrm(ks[27], (L, D), 0.02)
    ln3_b = nrm(ks[28], (L, D), 0.01)
    return {"x": x, "p": p, "w_in": w_in, "conv_w": conv_w, "conv_b": conv_b,
            "lru_wa": lru_wa, "lru_ba": lru_ba, "lru_wx": lru_wx, "lru_bx": lru_bx,
            "lru_lambda": lru_lambda, "diff_lq1": diff_lq1, "diff_lk1": diff_lk1,
            "diff_lq2": diff_lq2, "diff_lk2": diff_lk2, "diff_subln_g": diff_subln_g,
            "rel_bias": rel_bias, "w_out": w_out, "ln1_g": ln1_g, "ln1_b": ln1_b,
            "w_ffn_gate": w_ffn_gate, "w_ffn_up": w_ffn_up, "w_ffn_down": w_ffn_down,
            "ln2_g": ln2_g, "ln2_b": ln2_b, "w_ple_gate": w_ple_gate, "b_ple_gate": b_ple_gate,
            "w_ple_proj": w_ple_proj, "ln3_g": ln3_g, "ln3_b": ln3_b}


def reference(x, p, w_in, conv_w, conv_b, lru_wa, lru_ba, lru_wx, lru_bx, lru_lambda,
              diff_lq1, diff_lk1, diff_lq2, diff_lk2, diff_subln_g, rel_bias, w_out,
              ln1_g, ln1_b, w_ffn_gate, w_ffn_up, w_ffn_down, ln2_g, ln2_b,
              w_ple_gate, b_ple_gate, w_ple_proj, ln3_g, ln3_b):
    h = x
    for i in range(DEPTH):
        lam_init = 0.8 - 0.6 * math.exp(-0.3 * i)
        m = hybrid_mixer(h, w_in[i], conv_w[i], conv_b[i], lru_wa[i], lru_ba[i], lru_wx[i], lru_bx[i],
                         lru_lambda[i], diff_lq1[i], diff_lk1[i], diff_lq2[i], diff_lk2[i],
                         diff_subln_g[i], rel_bias, w_out[i], lam_init)
        h = layer_norm(ALPHA * h + m, ln1_g[i], ln1_b[i])
        f = swiglu(h, w_ffn_gate[i], w_ffn_up[i], w_ffn_down[i])
        h = layer_norm(ALPHA * h + f, ln2_g[i], ln2_b[i])
        gate = jax.nn.sigmoid(jnp.einsum('bsd,de->bse', h, w_ple_gate[i]) + b_ple_gate[i])
        e = jnp.einsum('bsk,kd->bsd', p[i], w_ple_proj[i])
        h = layer_norm(ALPHA * h + gate * e, ln3_g[i], ln3_b[i])
    return h
```

```cpp
#include <hip/hip_runtime.h>
#include <hip/hip_cooperative_groups.h>
#include <cstdio>
#include <cstdint>
namespace cg = cooperative_groups;
namespace pg8 {
#define PG8_LAS __attribute__((address_space(3)))
typedef unsigned short bf16_t;
typedef short bf16x8 __attribute__((ext_vector_type(8)));
typedef float f32x4 __attribute__((ext_vector_type(4)));
typedef unsigned u32x4 __attribute__((ext_vector_type(4)));
constexpr int BM = 256, BK = 64, HALF = 128, HTB = HALF * BK * 2  , STAGE_BYTES = 8 * HTB, NXCD = 8, WGM = 8;

__host__ __device__ __forceinline__ int lds_byte(int r, int c) { const int st = (r >> 4) * 2 + (c >> 5), rr = r & 15, cc = c & 31, ob = rr * 64 + cc * 2; return st * 1024 + (ob ^ (((ob >> 9) & 1) << 5)); }
__host__ __device__ __forceinline__ void stage_rc(int b, int& R, int& C) { const int st = b / 1024, sb = b % 1024, swz = sb ^ (((sb >> 9) & 1) << 5); R = (st >> 1) * 16 + swz / 64; C = (st & 1) * 32 + (swz % 64) / 2; }
__host__ __device__ __forceinline__ int perm32(int rho) { const int n = rho >> 4, i = rho & 15; return 8 * (i >> 2) + 4 * n + (i & 3); }

struct Unit { int pm, pn; };
struct Gemm { const bf16_t* A; const bf16_t* Bt; int M, N, K; };

struct StaticOrder {
    int nM, nN, nwg, G, c;
    __host__ __device__ void init(int M, int N, int G_, int c_) { nM = M / BM; nN = N / BM; nwg = nM * nN; G = G_; c = c_; }
    __host__ __device__ bool next(int i, Unit& u) const {
        const long L = (long)i * G + c; if (L >= nwg) return false;
        int wgid = (int)L; { const int q = nwg / NXCD, r = nwg % NXCD, xcd = wgid % NXCD, off = wgid / NXCD; wgid = (xcd < r ? xcd * (q + 1) : r * (q + 1) + (xcd - r) * q) + off; }
        const int nig = WGM * nN, gid = wgid / nig, fm = gid * WGM, gsz = (nM - fm) < WGM ? (nM - fm) : WGM;
        u.pm = fm + ((wgid % nig) % gsz); u.pn = (wgid % nig) / gsz; return true;
    }
    __device__ __forceinline__ void a_ready(const Unit&) const {}
    __device__ __forceinline__ void done(const Unit&) const {}
};

__device__ __forceinline__ unsigned cvt_pk_bf16(float lo, float hi) { unsigned r; asm volatile("v_cvt_pk_bf16_f32 %0, %1, %2" : "=v"(r) : "v"(lo), "v"(hi)); return r; }
typedef unsigned u32x2 __attribute__((ext_vector_type(2)));
__device__ __forceinline__ float fast_sigmoid(float x) { return __builtin_amdgcn_rcpf(1.0f + __builtin_amdgcn_exp2f(-1.4426950408889634f * x)); }
__device__ __forceinline__ float bf_lo(unsigned w) { return __uint_as_float(w << 16); }
__device__ __forceinline__ float bf_hi(unsigned w) { return __uint_as_float(w & 0xffff0000u); }

struct EpiBf16 {
    static constexpr bool PERM = true, AFTER_DRAIN = false;
    bf16_t* O; int ldc;
    __device__ __forceinline__ void operator()(const f32x4 (&acc)[2][2][4][2], const Unit& u, int wr, int wc, int fr, int fq) const {
        const int row0 = u.pm * BM + wr * 64 + fr; const int col0 = u.pn * BM + wc * 32 + 8 * fq;
#pragma unroll
        for (int ai = 0; ai < 2; ++ai)
#pragma unroll
            for (int m = 0; m < 4; ++m) { bf16_t* rowp = O + (size_t)(row0 + ai * HALF + m * 16) * ldc + col0;
#pragma unroll
                for (int bj = 0; bj < 2; ++bj) { const f32x4 v0 = acc[ai][bj][m][0], v1 = acc[ai][bj][m][1];
                    u32x4 w; w.x = cvt_pk_bf16(v0[0], v0[1]); w.y = cvt_pk_bf16(v0[2], v0[3]); w.z = cvt_pk_bf16(v1[0], v1[1]); w.w = cvt_pk_bf16(v1[2], v1[3]);
                    *(u32x4*)(rowp + bj * HALF) = w; } }
    }
};
struct EpiSwiglu {
    static constexpr bool PERM = true, AFTER_DRAIN = false;
    bf16_t* O; int ldc;
    __device__ __forceinline__ void operator()(const f32x4 (&acc)[2][2][4][2], const Unit& u, int wr, int wc, int fr, int fq) const {
        const int row0 = u.pm * BM + wr * 64 + fr; const int col0 = u.pn * HALF + wc * 32 + 8 * fq;
#pragma unroll
        for (int ai = 0; ai < 2; ++ai)
#pragma unroll
            for (int m = 0; m < 4; ++m) { bf16_t* rowp = O + (size_t)(row0 + ai * HALF + m * 16) * ldc + col0;
                float v[8];
#pragma unroll
                for (int n = 0; n < 2; ++n)
#pragma unroll
                    for (int i = 0; i < 4; ++i) { const float g = acc[ai][0][m][n][i], up = acc[ai][1][m][n][i];
                        v[n * 4 + i] = g * up * __builtin_amdgcn_rcpf(1.0f + __builtin_amdgcn_exp2f(g)); }
                u32x4 w; w.x = cvt_pk_bf16(v[0], v[1]); w.y = cvt_pk_bf16(v[2], v[3]); w.z = cvt_pk_bf16(v[4], v[5]); w.w = cvt_pk_bf16(v[6], v[7]);
                *(u32x4*)rowp = w; }
    }
};
#define PG8_GAS __attribute__((address_space(1)))
struct EpiRes {
    static constexpr bool PERM = true, AFTER_DRAIN = false;
    const float* res; bf16_t* out; int ldc; float alpha;
    __device__ __forceinline__ void operator()(const f32x4 (&acc)[2][2][4][2], const Unit& u, int wr, int wc, int fr, int fq) const {
        const int col0 = u.pn * BM + wc * 32 + 8 * fq; const int rowb = u.pm * BM + wr * 64 + fr;
        const unsigned off0 = (unsigned)(rowb * 2048 + col0);
#define PG8_ROFF(k) (off0 + (unsigned)((((k) >> 2) * HALF + ((k) & 3) * 16) * 2048))
#pragma unroll
        for (int bj = 0; bj < 2; ++bj) { const int c = bj * HALF;
            f32x4 n0 = *(const PG8_GAS f32x4*)(res + PG8_ROFF(0) + c), n1 = *(const PG8_GAS f32x4*)(res + PG8_ROFF(0) + c + 4);
#pragma unroll
            for (int k = 0; k < 8; ++k) { const f32x4 r0 = n0, r1 = n1;
                if (k < 7) { n0 = *(const PG8_GAS f32x4*)(res + PG8_ROFF(k + 1) + c); n1 = *(const PG8_GAS f32x4*)(res + PG8_ROFF(k + 1) + c + 4); }
                const unsigned o = PG8_ROFF(k) + c;
                const f32x4 y0 = r0 * alpha + acc[k >> 2][bj][k & 3][0], y1 = r1 * alpha + acc[k >> 2][bj][k & 3][1];
                u32x4 w; w.x = cvt_pk_bf16(y0[0], y0[1]); w.y = cvt_pk_bf16(y0[2], y0[3]); w.z = cvt_pk_bf16(y1[0], y1[1]); w.w = cvt_pk_bf16(y1[2], y1[3]); *(PG8_GAS u32x4*)(out + o) = w; } }
    }
};
struct EpiPle {
    static constexpr bool PERM = true, AFTER_DRAIN = false;
    const float* res; const bf16_t* e; const float* bias; float* out; int ldc; float alpha;
    __device__ __forceinline__ void operator()(const f32x4 (&acc)[2][2][4][2], const Unit& u, int wr, int wc, int fr, int fq) const {
        const int col0 = u.pn * BM + wc * 32 + 8 * fq; const int rowb = u.pm * BM + wr * 64 + fr;
        const unsigned off0 = (unsigned)(rowb * 2048 + col0);
#pragma unroll
        for (int bj = 0; bj < 2; ++bj) { const int c = bj * HALF;
            const f32x4 b0 = *(const PG8_GAS f32x4*)(bias + col0 + c), b1 = *(const PG8_GAS f32x4*)(bias + col0 + c + 4);
            f32x4 n0 = *(const PG8_GAS f32x4*)(res + PG8_ROFF(0) + c), n1 = *(const PG8_GAS f32x4*)(res + PG8_ROFF(0) + c + 4); u32x4 en = *(const PG8_GAS u32x4*)(e + PG8_ROFF(0) + c);
#pragma unroll
            for (int k = 0; k < 8; ++k) { const f32x4 r0 = n0, r1 = n1; const u32x4 ew = en;
                if (k < 7) { n0 = *(const PG8_GAS f32x4*)(res + PG8_ROFF(k + 1) + c); n1 = *(const PG8_GAS f32x4*)(res + PG8_ROFF(k + 1) + c + 4); en = *(const PG8_GAS u32x4*)(e + PG8_ROFF(k + 1) + c); }
                const f32x4 a0 = acc[k >> 2][bj][k & 3][0] + b0, a1 = acc[k >> 2][bj][k & 3][1] + b1;
                const f32x4 e0 = (f32x4){bf_lo(ew.x), bf_hi(ew.x), bf_lo(ew.y), bf_hi(ew.y)}, e1 = (f32x4){bf_lo(ew.z), bf_hi(ew.z), bf_lo(ew.w), bf_hi(ew.w)};
                f32x4 s0, s1;
#pragma unroll
                for (int i = 0; i < 4; ++i) { s0[i] = fast_sigmoid(a0[i]); s1[i] = fast_sigmoid(a1[i]); }
                const unsigned o = PG8_ROFF(k) + c;
                *(PG8_GAS f32x4*)(out + o) = r0 * alpha + s0 * e0; *(PG8_GAS f32x4*)(out + o + 4) = r1 * alpha + s1 * e1; } }
#undef PG8_ROFF
    }
};

struct EpiResB {
    static constexpr bool PERM = true, AFTER_DRAIN = false;
    const bf16_t* res; bf16_t* out; float alpha;
    __device__ __forceinline__ void operator()(const f32x4 (&acc)[2][2][4][2], const Unit& u, int wr, int wc, int fr, int fq) const {
        const int col0 = u.pn * BM + wc * 32 + 8 * fq; const int rowb = u.pm * BM + wr * 64 + fr;
        const unsigned off0 = (unsigned)(rowb * 2048 + col0);
#define PG8_ROFF(k) (off0 + (unsigned)((((k) >> 2) * HALF + ((k) & 3) * 16) * 2048))
#pragma unroll
        for (int bj = 0; bj < 2; ++bj) { const int c = bj * HALF;
            u32x4 nn = *(const PG8_GAS u32x4*)(res + PG8_ROFF(0) + c);
#pragma unroll
            for (int k = 0; k < 8; ++k) { const u32x4 rw = nn;
                if (k < 7) nn = *(const PG8_GAS u32x4*)(res + PG8_ROFF(k + 1) + c);
                const f32x4 r0 = (f32x4){bf_lo(rw.x), bf_hi(rw.x), bf_lo(rw.y), bf_hi(rw.y)}, r1 = (f32x4){bf_lo(rw.z), bf_hi(rw.z), bf_lo(rw.w), bf_hi(rw.w)};
                const unsigned o = PG8_ROFF(k) + c;
                const f32x4 y0 = r0 * alpha + acc[k >> 2][bj][k & 3][0], y1 = r1 * alpha + acc[k >> 2][bj][k & 3][1];
                u32x4 w; w.x = cvt_pk_bf16(y0[0], y0[1]); w.y = cvt_pk_bf16(y0[2], y0[3]); w.z = cvt_pk_bf16(y1[0], y1[1]); w.w = cvt_pk_bf16(y1[2], y1[3]); *(PG8_GAS u32x4*)(out + o) = w; } }
    }
};
struct EpiPleB {
    static constexpr bool PERM = true, AFTER_DRAIN = false;
    const bf16_t* res; const bf16_t* e; const float* bias; bf16_t* out; float alpha;
    __device__ __forceinline__ void operator()(const f32x4 (&acc)[2][2][4][2], const Unit& u, int wr, int wc, int fr, int fq) const {
        const int col0 = u.pn * BM + wc * 32 + 8 * fq; const int rowb = u.pm * BM + wr * 64 + fr;
        const unsigned off0 = (unsigned)(rowb * 2048 + col0);
#pragma unroll
        for (int bj = 0; bj < 2; ++bj) { const int c = bj * HALF;
            const f32x4 b0 = *(const PG8_GAS f32x4*)(bias + col0 + c), b1 = *(const PG8_GAS f32x4*)(bias + col0 + c + 4);
            u32x4 nn = *(const PG8_GAS u32x4*)(res + PG8_ROFF(0) + c), en = *(const PG8_GAS u32x4*)(e + PG8_ROFF(0) + c);
#pragma unroll
            for (int k = 0; k < 8; ++k) { const u32x4 rw = nn, ew = en;
                if (k < 7) { nn = *(const PG8_GAS u32x4*)(res + PG8_ROFF(k + 1) + c); en = *(const PG8_GAS u32x4*)(e + PG8_ROFF(k + 1) + c); }
                const f32x4 r0 = (f32x4){bf_lo(rw.x), bf_hi(rw.x), bf_lo(rw.y), bf_hi(rw.y)}, r1 = (f32x4){bf_lo(rw.z), bf_hi(rw.z), bf_lo(rw.w), bf_hi(rw.w)};
                const f32x4 a0 = acc[k >> 2][bj][k & 3][0] + b0, a1 = acc[k >> 2][bj][k & 3][1] + b1;
                const f32x4 e0 = (f32x4){bf_lo(ew.x), bf_hi(ew.x), bf_lo(ew.y), bf_hi(ew.y)}, e1 = (f32x4){bf_lo(ew.z), bf_hi(ew.z), bf_lo(ew.w), bf_hi(ew.w)};
                f32x4 s0, s1;
#pragma unroll
                for (int i = 0; i < 4; ++i) { s0[i] = fast_sigmoid(a0[i]); s1[i] = fast_sigmoid(a1[i]); }
                const unsigned o = PG8_ROFF(k) + c;
                const f32x4 y0 = r0 * alpha + s0 * e0, y1 = r1 * alpha + s1 * e1;
                u32x4 w; w.x = cvt_pk_bf16(y0[0], y0[1]); w.y = cvt_pk_bf16(y0[2], y0[3]); w.z = cvt_pk_bf16(y1[0], y1[1]); w.w = cvt_pk_bf16(y1[2], y1[3]); *(PG8_GAS u32x4*)(out + o) = w; } }
#undef PG8_ROFF
    }
};
template <class Epi, class Sched, bool ALIGN_EPI = false, bool SP2 = false>
__device__ __forceinline__ void gemm_phase(PG8_LAS unsigned char* lds, const Gemm g, const Sched& S, const Epi& E) {
    const int tid = threadIdx.x, wid = __builtin_amdgcn_readfirstlane(tid >> 6), lane = tid & 63, wr = wid >> 2, wc = wid & 3, fr = lane & 15, fq = lane >> 4;
    const int K = g.K, nt = K / BK;
    unsigned voffA[2], voffB[2];
#pragma unroll
    for (int i = 0; i < 2; ++i) { int R, C; stage_rc(tid * 16 + i * 8192, R, C); const int Rb = Epi::PERM ? ((R & ~31) + perm32(R & 31)) : R;
        voffA[i] = (unsigned)(R * K + C) * 2u; voffB[i] = (unsigned)(Rb * K + C) * 2u; }
    const size_t kstep = (size_t)(BK * 2);
    const size_t hstep = (size_t)HALF * K * 2;
    const size_t tstep = 2 * hstep;
    const unsigned ldsw = (unsigned)wid * 1024u;
    const int aoff = lds_byte(wr * 64 + fr, fq * 8), boff = lds_byte(wc * 32 + fr, fq * 8);
#define PG8_SA(b, h) (((b) * 2 + (h)) * HTB)
#define PG8_SB(b, h) ((4 + (b) * 2 + (h)) * HTB)
#define PG8_STAGE(bufoff, gbase, voff) do { _Pragma("unroll") for (int _i = 0; _i < 2; ++_i) \
        __builtin_amdgcn_global_load_lds((const unsigned*)((const char*)(gbase) + (voff)[_i]), (PG8_LAS unsigned*)(lds + (bufoff) + ldsw + _i * 8192), 16, 0, 0); } while (0)
#define PG8_LDA(dst, b, h) do { _Pragma("unroll") for (int m = 0; m < 4; ++m) _Pragma("unroll") for (int k = 0; k < 2; ++k) dst[m][k] = *(const PG8_LAS bf16x8*)(lds + PG8_SA(b, h) + aoff + m * 2048 + k * 1024); } while (0)
#define PG8_LDB(dst, b, h) do { _Pragma("unroll") for (int n = 0; n < 2; ++n) _Pragma("unroll") for (int k = 0; k < 2; ++k) dst[n][k] = *(const PG8_LAS bf16x8*)(lds + PG8_SB(b, h) + boff + n * 2048 + k * 1024); } while (0)
#define PG8_MMA(ai, bj, At, Bt) do { __builtin_amdgcn_s_setprio(1); _Pragma("unroll") for (int m = 0; m < 4; ++m) _Pragma("unroll") for (int n = 0; n < 2; ++n) _Pragma("unroll") for (int k = 0; k < 2; ++k) \
        acc[ai][bj][m][n] = __builtin_amdgcn_mfma_f32_16x16x32_bf16(Bt[n][k], At[m][k], acc[ai][bj][m][n], 0, 0, 0); __builtin_amdgcn_s_setprio(0); } while (0)
#define PG8_WAIT_V(n) asm volatile("s_waitcnt vmcnt(" #n ")" ::: "memory")
#define PG8_WAIT_L(n) asm volatile("s_waitcnt lgkmcnt(" #n ")" ::: "memory")
#define PG8_BAR __builtin_amdgcn_s_barrier()
#define PG8_SCHED __builtin_amdgcn_sched_barrier(0)
    Unit cur, nxt; int ui = 0;
    if (!S.next(0, cur)) return;
    f32x4 acc[2][2][4][2];
#pragma unroll
    for (int a = 0; a < 2; ++a)
#pragma unroll
        for (int b = 0; b < 2; ++b)
#pragma unroll
            for (int m = 0; m < 4; ++m)
#pragma unroll
                for (int n = 0; n < 2; ++n) acc[a][b][m][n] = (f32x4){0.f, 0.f, 0.f, 0.f};
    bf16x8 At[4][2], B0[2][2], B1[2][2];
    const char* cA = (const char*)g.A + (size_t)cur.pm * tstep; const char* cB = (const char*)g.Bt + (size_t)cur.pn * tstep;
    S.a_ready(cur);
    if constexpr (SP2) {
        PG8_STAGE(PG8_SB(0, 0), cB, voffB); PG8_STAGE(PG8_SB(0, 1), cB + hstep, voffB); PG8_STAGE(PG8_SA(0, 0), cA, voffA); PG8_STAGE(PG8_SA(0, 1), cA + hstep, voffA);
        if (wr == 1) PG8_BAR;
        PG8_WAIT_V(2); PG8_BAR;
        PG8_STAGE(PG8_SB(1, 0), cB + kstep, voffB); PG8_STAGE(PG8_SA(1, 0), cA + kstep, voffA); PG8_STAGE(PG8_SB(1, 1), cB + hstep + kstep, voffB);
        PG8_WAIT_V(6); PG8_BAR;
    } else {
        PG8_STAGE(PG8_SB(0, 0), cB, voffB); PG8_STAGE(PG8_SA(0, 0), cA, voffA); PG8_STAGE(PG8_SB(0, 1), cB + hstep, voffB); PG8_STAGE(PG8_SA(0, 1), cA + hstep, voffA);
        if (wr == 1) PG8_BAR;
        PG8_WAIT_V(4); PG8_BAR;
        PG8_STAGE(PG8_SB(1, 0), cB + kstep, voffB); PG8_STAGE(PG8_SA(1, 0), cA + kstep, voffA); PG8_STAGE(PG8_SB(1, 1), cB + hstep + kstep, voffB);
        PG8_WAIT_V(6); PG8_BAR;
    }
    for (;;) {
        const bool has_next = S.next(ui + 1, nxt);
        const char* nA = has_next ? (const char*)g.A + (size_t)nxt.pm * tstep : cA; const char* nB = has_next ? (const char*)g.Bt + (size_t)nxt.pn * tstep : cB;
        for (int t = 0; t < nt; t += 2) {
            const bool last = (t == nt - 2);
            const char* a1 = cA + (size_t)(t + 1) * kstep;
            const char* a2 = last ? nA : cA + (size_t)(t + 2) * kstep; const char* b2 = last ? nB : cB + (size_t)(t + 2) * kstep;
            const char* a3 = a2 + kstep; const char* b3 = b2 + kstep;
            if (last && has_next) S.a_ready(nxt);
            if constexpr (SP2) {
            PG8_LDB(B0, 0, 0); PG8_LDB(B1, 0, 1); PG8_SCHED; PG8_LDA(At, 0, 0); PG8_STAGE(PG8_SA(1, 1), a1 + hstep, voffA);
            PG8_WAIT_V(8); PG8_WAIT_L(0); PG8_BAR; PG8_MMA(0, 0, At, B0); PG8_MMA(0, 1, At, B1); PG8_BAR; PG8_SCHED;
            PG8_LDA(At, 0, 1); PG8_STAGE(PG8_SB(0, 0), b2, voffB); PG8_STAGE(PG8_SB(0, 1), b2 + hstep, voffB); PG8_STAGE(PG8_SA(0, 0), a2, voffA);
            PG8_WAIT_V(8); PG8_WAIT_L(0); PG8_BAR; PG8_MMA(1, 0, At, B0); PG8_MMA(1, 1, At, B1); PG8_BAR; PG8_SCHED;
            PG8_LDB(B0, 1, 0); PG8_LDB(B1, 1, 1); PG8_SCHED; PG8_LDA(At, 1, 0); PG8_STAGE(PG8_SA(0, 1), a2 + hstep, voffA);
            PG8_WAIT_V(8); PG8_WAIT_L(0); PG8_BAR; PG8_MMA(0, 0, At, B0); PG8_MMA(0, 1, At, B1); PG8_BAR; PG8_SCHED;
            PG8_LDA(At, 1, 1); PG8_STAGE(PG8_SB(1, 0), b3, voffB); PG8_STAGE(PG8_SB(1, 1), b3 + hstep, voffB); PG8_STAGE(PG8_SA(1, 0), a3, voffA);
            PG8_WAIT_V(8); PG8_WAIT_L(0); PG8_BAR; PG8_MMA(1, 0, At, B0); PG8_MMA(1, 1, At, B1); PG8_BAR; PG8_SCHED;
            } else {
            PG8_LDB(B0, 0, 0); PG8_SCHED; PG8_LDA(At, 0, 0); PG8_STAGE(PG8_SA(1, 1), a1 + hstep, voffA);
            PG8_WAIT_L(8); PG8_BAR; PG8_WAIT_L(0); PG8_MMA(0, 0, At, B0); PG8_BAR; PG8_SCHED;
            PG8_LDB(B1, 0, 1); PG8_STAGE(PG8_SB(0, 0), b2, voffB);
            PG8_BAR; PG8_WAIT_L(0); PG8_MMA(0, 1, At, B1); PG8_BAR;
            PG8_LDA(At, 0, 1); PG8_STAGE(PG8_SA(0, 0), a2, voffA);
            PG8_BAR; PG8_WAIT_L(0); PG8_MMA(1, 0, At, B0); PG8_BAR; PG8_SCHED;
            PG8_STAGE(PG8_SB(0, 1), b2 + hstep, voffB);
            PG8_WAIT_V(6); PG8_BAR; PG8_MMA(1, 1, At, B1); PG8_BAR;
            PG8_LDB(B0, 1, 0); PG8_SCHED; PG8_LDA(At, 1, 0); PG8_STAGE(PG8_SA(0, 1), a2 + hstep, voffA);
            PG8_WAIT_L(8); PG8_BAR; PG8_WAIT_L(0); PG8_MMA(0, 0, At, B0); PG8_BAR; PG8_SCHED;
            PG8_LDB(B1, 1, 1); PG8_STAGE(PG8_SB(1, 0), b3, voffB);
            PG8_BAR; PG8_WAIT_L(0); PG8_MMA(0, 1, At, B1); PG8_BAR;
            PG8_LDA(At, 1, 1); PG8_STAGE(PG8_SA(1, 0), a3, voffA);
            PG8_BAR; PG8_WAIT_L(0); PG8_MMA(1, 0, At, B0); PG8_BAR; PG8_SCHED;
            PG8_STAGE(PG8_SB(1, 1), b3 + hstep, voffB);
            PG8_WAIT_V(6); PG8_BAR; PG8_MMA(1, 1, At, B1); PG8_BAR;
            }
        }
        if constexpr (ALIGN_EPI) { if (wr == 0) PG8_BAR; }
        if constexpr (!Epi::AFTER_DRAIN) { E(acc, cur, wr, wc, fr, fq); S.done(cur); }
        if (!has_next) break;
#pragma unroll
        for (int a = 0; a < 2; ++a)
#pragma unroll
            for (int b = 0; b < 2; ++b)
#pragma unroll
                for (int m = 0; m < 4; ++m)
#pragma unroll
                    for (int n = 0; n < 2; ++n) acc[a][b][m][n] = (f32x4){0.f, 0.f, 0.f, 0.f};
        cur = nxt; cA = nA; cB = nB; ++ui;
        if constexpr (ALIGN_EPI) { if (wr == 1) PG8_BAR; }
    }
    PG8_WAIT_V(0);
    if constexpr (!ALIGN_EPI) { if (wr == 0) PG8_BAR; }
    PG8_BAR;
    if constexpr (Epi::AFTER_DRAIN) { E.fused(acc, cur, wr, wc, fr, fq, lds, wid, lane); S.done(cur); }
#undef PG8_SA
#undef PG8_SB
#undef PG8_STAGE
#undef PG8_LDA
#undef PG8_LDB
#undef PG8_MMA
#undef PG8_WAIT_V
#undef PG8_WAIT_L
#undef PG8_BAR
#undef PG8_SCHED
}
}

#define LAS __attribute__((address_space(3)))
typedef unsigned short bf16;
typedef unsigned u32x4 __attribute__((ext_vector_type(4)));
typedef unsigned u32x2 __attribute__((ext_vector_type(2)));
typedef float f32x4 __attribute__((ext_vector_type(4)));
typedef float f32x16 __attribute__((ext_vector_type(16)));
typedef short bf16x8 __attribute__((ext_vector_type(8)));
typedef short s16x4 __attribute__((ext_vector_type(4)));

constexpr int NWAVES = 8;
constexpr int BATCH = 16, SEQ = 2048, D = 2048, M = BATCH * SEQ;
constexpr int LRU_W = 1024, IN_W = 5120, FFN = 5632, PLE = 256, NH = 8;
constexpr int QOFF = 2048, KOFF = 3072, VOFF = 4096;
constexpr float LN_EPS = 1e-5f;
constexpr float ALPHA = 1.189207115002721f;
constexpr float LAM_INIT = 0.2f;
constexpr float LOG2E = 1.4426950408889634f;
constexpr float QSCALE = 0.125f * LOG2E;

constexpr size_t MiB = 1u << 20;
constexpr size_t WS_WIN = 0, WS_WOUT = 20 * MiB, WS_WGU = 28 * MiB, WS_WDN = 72 * MiB, WS_WPG = 94 * MiB, WS_WPP = 102 * MiB, WS_WLRU = 103 * MiB;
constexpr size_t WS_PB = 104 * MiB;
constexpr size_t WS_R = 120 * MiB;
constexpr size_t WS_E = 472 * MiB;
constexpr size_t WS_MG = 600 * MiB;
constexpr size_t WS_Y = 728 * MiB;
constexpr size_t WS_CTL = 984 * MiB, CTL_BYTES = 16384;
constexpr size_t WS_END = 985 * MiB;

constexpr int LDS_BYTES = 131072 + 4096;

__device__ __forceinline__ unsigned f2bf(float f) { unsigned u = __builtin_bit_cast(unsigned, f); return (u + 0x7fffu + ((u >> 16) & 1u)) >> 16; }
__device__ __forceinline__ unsigned pk2(float lo, float hi) { return f2bf(lo) | (f2bf(hi) << 16); }
__device__ __forceinline__ float bflo(unsigned w) { return __uint_as_float(w << 16); }
__device__ __forceinline__ float bfhi(unsigned w) { return __uint_as_float(w & 0xffff0000u); }
__device__ __forceinline__ float wave_sum(float v) {
#pragma unroll
    for (int o = 1; o < 64; o <<= 1) v += __shfl_xor(v, o);
    return v;
}
__device__ __forceinline__ float sigmoidf_(float x) { return __builtin_amdgcn_rcpf(1.0f + __builtin_amdgcn_exp2f(-LOG2E * x)); }

__device__ __forceinline__ void tr_item(const float* W, int ldw, int k0, int n0, bf16* WT, size_t drow0, int ldk, float scale, LAS float* scr, int lane) {
    float wv[32];
#pragma unroll
    for (int i = 0; i < 32; ++i) wv[i] = W[(size_t)(k0 + 2 * i + (lane >> 5)) * ldw + n0 + (lane & 31)];
#pragma unroll
    for (int i = 0; i < 32; ++i) scr[(2 * i + (lane >> 5)) * 33 + (lane & 31)] = wv[i];
    asm volatile("s_waitcnt lgkmcnt(0)" ::: "memory");
    const int c = lane & 7;
#pragma unroll
    for (int j = 0; j < 4; ++j) { const int n = (lane >> 3) + 8 * j; const LAS float* s = scr + (8 * c) * 33 + n;
        u32x4 o; o.x = pk2(s[0 * 33] * scale, s[1 * 33] * scale); o.y = pk2(s[2 * 33] * scale, s[3 * 33] * scale); o.z = pk2(s[4 * 33] * scale, s[5 * 33] * scale); o.w = pk2(s[6 * 33] * scale, s[7 * 33] * scale);
        *(u32x4*)(WT + (drow0 + n) * ldk + k0 + 8 * c) = o; }
    asm volatile("s_waitcnt lgkmcnt(0)" ::: "memory");
}
struct P0Args { const float *x, *p, *w_in, *w_out, *w_gate, *w_up, *w_down, *w_pg, *w_pp, *lru_wa, *lru_wx; bf16 *Win, *Wout, *Wgu, *Wdn, *Wpg, *Wpp, *Wlru, *xb, *pb; };
__device__ __forceinline__ void p0_prologue(const P0Args& A, LAS unsigned char* lds, int gw, int NGW, int wave, int lane) {
    LAS float* scr = (LAS float*)(lds + wave * 8448);
    constexpr int I_IN = (D / 64) * (IN_W / 32), I_OUT = (D / 64) * (D / 32), I_G = (D / 64) * (FFN / 32), I_DN = (FFN / 64) * (D / 32), I_PG = I_OUT, I_PP = (PLE / 64) * (D / 32), I_L = 8 * 2 * 4;
    constexpr int NITEMS = I_IN + I_OUT + 2 * I_G + I_DN + I_PG + I_PP + 2 * I_L;
    for (int it = gw; it < NITEMS; it += NGW) {
        int r = it;
        if (r < I_IN) { const int nb = IN_W / 32, k0 = 64 * (r / nb), n0 = 32 * (r % nb); tr_item(A.w_in, IN_W, k0, n0, A.Win, n0, D, (n0 >= QOFF && n0 < KOFF) ? QSCALE : 1.f, scr, lane); continue; } r -= I_IN;
        if (r < I_OUT) { const int nb = D / 32, k0 = 64 * (r / nb), n0 = 32 * (r % nb); tr_item(A.w_out, D, k0, n0, A.Wout, n0, D, 1.f, scr, lane); continue; } r -= I_OUT;
        if (r < 2 * I_G) { const int up = r >= I_G; if (up) r -= I_G; const int nb = FFN / 32, k0 = 64 * (r / nb), n0 = 32 * (r % nb);
            tr_item(up ? A.w_up : A.w_gate, FFN, k0, n0, A.Wgu, (size_t)(n0 / 128) * 256 + (n0 % 128) + (up ? 128 : 0), D, up ? -0.6931471805599453f : -LOG2E, scr, lane); continue; } r -= 2 * I_G;
        if (r < I_DN) { const int nb = D / 32, k0 = 64 * (r / nb), n0 = 32 * (r % nb); tr_item(A.w_down, D, k0, n0, A.Wdn, n0, FFN, 1.f, scr, lane); continue; } r -= I_DN;
        if (r < I_PG) { const int nb = D / 32, k0 = 64 * (r / nb), n0 = 32 * (r % nb); tr_item(A.w_pg, D, k0, n0, A.Wpg, n0, D, 1.f, scr, lane); continue; } r -= I_PG;
        if (r < I_PP) { const int nb = D / 32, k0 = 64 * (r / nb), n0 = 32 * (r % nb); tr_item(A.w_pp, D, k0, n0, A.Wpp, n0, PLE, 1.f, scr, lane); continue; } r -= I_PP;
        { const int isx = r >= I_L; if (isx) r -= I_L; const int n = r >> 3, k0 = 64 * ((r >> 2) & 1), n0 = 32 * (r & 3);
          tr_item((isx ? A.lru_wx : A.lru_wa) + (size_t)n * 128 * 128, 128, k0, n0, A.Wlru + (size_t)n * 256 * 128, n0 + (isx ? 128 : 0), 128, 1.f, scr, lane); }
    }
    const size_t gt = (size_t)gw * 64 + lane, NT = (size_t)NGW * 64;
#pragma unroll 4
    for (size_t i = gt; i < (size_t)M * D / 8; i += NT) { const f32x4 a = *(const f32x4*)(A.x + i * 8), b = *(const f32x4*)(A.x + i * 8 + 4);
        u32x4 o; o.x = pk2(a[0], a[1]); o.y = pk2(a[2], a[3]); o.z = pk2(b[0], b[1]); o.w = pk2(b[2], b[3]); *(u32x4*)(A.xb + i * 8) = o; }
#pragma unroll 4
    for (size_t i = gt; i < (size_t)M * PLE / 8; i += NT) { const f32x4 a = *(const f32x4*)(A.p + i * 8), b = *(const f32x4*)(A.p + i * 8 + 4);
        u32x4 o; o.x = pk2(a[0], a[1]); o.y = pk2(a[2], a[3]); o.z = pk2(b[0], b[1]); o.w = pk2(b[2], b[3]); *(u32x4*)(A.pb + i * 8) = o; }
}

__device__ __forceinline__ void ln_rows(const bf16* Yb, const float* g, const float* bt, float* outf, bf16* outb, int gw, int NGW, int lane) {
    u32x4 nx[4];
    if (gw < M) { const u32x4* yr = (const u32x4*)(Yb + (size_t)gw * D) + lane;
#pragma unroll
        for (int j = 0; j < 4; ++j) nx[j] = yr[64 * j]; }
    for (int row = gw; row < M; row += NGW) {
        float v[4][8]; float s = 0.f;
#pragma unroll
        for (int j = 0; j < 4; ++j) { const u32x4 w = nx[j]; v[j][0] = bflo(w.x); v[j][1] = bfhi(w.x); v[j][2] = bflo(w.y); v[j][3] = bfhi(w.y); v[j][4] = bflo(w.z); v[j][5] = bfhi(w.z); v[j][6] = bflo(w.w); v[j][7] = bfhi(w.w);
            s += ((v[j][0] + v[j][1]) + (v[j][2] + v[j][3])) + ((v[j][4] + v[j][5]) + (v[j][6] + v[j][7])); }
        if (row + NGW < M) { const u32x4* yr = (const u32x4*)(Yb + (size_t)(row + NGW) * D) + lane;
#pragma unroll
            for (int j = 0; j < 4; ++j) nx[j] = yr[64 * j]; }
        const float mean = wave_sum(s) * (1.f / D); float s2 = 0.f;
#pragma unroll
        for (int j = 0; j < 4; ++j)
#pragma unroll
            for (int i = 0; i < 8; ++i) { v[j][i] -= mean; s2 += v[j][i] * v[j][i]; }
        const float rstd = 1.f / sqrtf(wave_sum(s2) * (1.f / D) + LN_EPS);
#pragma unroll
        for (int j = 0; j < 4; ++j) { const int col = 8 * (lane + 64 * j);
            const f32x4 g0 = *(const f32x4*)(g + col), g1 = *(const f32x4*)(g + col + 4), b0 = *(const f32x4*)(bt + col), b1 = *(const f32x4*)(bt + col + 4);
            const f32x4 o0 = (f32x4){v[j][0], v[j][1], v[j][2], v[j][3]} * rstd * g0 + b0, o1 = (f32x4){v[j][4], v[j][5], v[j][6], v[j][7]} * rstd * g1 + b1;
            if (outf) { *(f32x4*)(outf + (size_t)row * D + col) = o0; *(f32x4*)(outf + (size_t)row * D + col + 4) = o1; }
            if (outb) { u32x4 w; w.x = pk2(o0[0], o0[1]); w.y = pk2(o0[2], o0[3]); w.z = pk2(o1[0], o1[1]); w.w = pk2(o1[2], o1[3]); *(u32x4*)(outb + (size_t)row * D + col) = w; } }
    }
}

namespace lru {
__device__ __forceinline__ float nexpm1(float x) { const float p = -x * (1.0f + x * (0.5f + x * (0.16666667f + x * (0.041666668f + x * (0.0083333338f + x * 0.0013888889f)))));
    const float d = 1.0f - __builtin_amdgcn_exp2f(LOG2E * x); return x > -0.25f ? p : d; }
constexpr int TC = 128, RS = 272;
constexpr int L_XC = 0, L_WL = L_XC + TC * RS, L_XCF = L_WL + 64 * RS, L_AS = L_XCF + TC * 32 * 4, L_US = L_AS + TC * 32 * 4, L_END = L_US + TC * 32 * 4;
static_assert(L_END <= 131072, "lru lds");
struct Args { const bf16* proj; const bf16* Wlru; const float *conv_w, *conv_b, *ba, *bx, *lam; bf16* merged; };
__device__ __forceinline__ void unit(const Args& A, LAS unsigned char* lds, int un) {
    const int tid = threadIdx.x, lane = tid & 63, wid = __builtin_amdgcn_readfirstlane(tid >> 6), fr = lane & 15, fq = lane >> 4;
    const int b = un >> 5, n = (un >> 2) & 7, qd = un & 3;
    LAS float* XCF = (LAS float*)(lds + L_XCF); LAS float* AS = (LAS float*)(lds + L_AS); LAS float* US = (LAS float*)(lds + L_US);
#pragma unroll
    for (int i = 0; i < 2; ++i) { const int idx = tid + 512 * i, row = idx >> 4, ch = idx & 15; const int srow = n * 256 + (row < 32 ? 32 * qd + row : 128 + 32 * qd + row - 32);
        *(LAS u32x4*)(lds + L_WL + row * RS + ch * 16) = *(const u32x4*)(A.Wlru + (size_t)srow * 128 + ch * 8); }
    float ba[2], bx[2], sp8[2];
#pragma unroll
    for (int t2 = 0; t2 < 2; ++t2) { const int ch = n * 128 + 32 * qd + 16 * t2 + fr; ba[t2] = A.ba[ch]; bx[t2] = A.bx[ch];
        const float L = A.lam[ch]; sp8[t2] = 8.0f * (fmaxf(-L, 0.f) + log1pf(expf(-fabsf(L)))); }
    const int cg8 = tid & 15;
    float cw[4][8], cb[8];
#pragma unroll
    for (int j = 0; j < 8; ++j) { const int ch = n * 128 + cg8 * 8 + j; cb[j] = A.conv_b[ch];
#pragma unroll
        for (int t = 0; t < 4; ++t) cw[t][j] = A.conv_w[t * LRU_W + ch]; }
    float hc[2] = {0.f, 0.f};
    const bf16* xbase = A.proj + (size_t)b * SEQ * IN_W + n * 128 + cg8 * 8;
    u32x4 xw[4][4];
#define LRU_LOAD_X(T0) _Pragma("unroll") for (int k = 0; k < 4; ++k) _Pragma("unroll") for (int tp = 0; tp < 4; ++tp) { const int tt = (T0) + (tid >> 4) + 32 * k - 3 + tp; \
        xw[k][tp] = tt >= 0 ? *(const u32x4*)(xbase + (size_t)tt * IN_W) : (u32x4){0u, 0u, 0u, 0u}; }
    LRU_LOAD_X(0)
    for (int ci = 0; ci < SEQ / TC; ++ci) {
        const int t0 = ci * TC;
        const u32x4 yw = *(const u32x4*)(A.proj + ((size_t)b * SEQ + t0 + (tid >> 2)) * IN_W + LRU_W + n * 128 + 32 * qd + (tid & 3) * 8);
#pragma unroll
        for (int k = 0; k < 4; ++k) { const int tok = (tid >> 4) + 32 * k;
            float acc[8];
#pragma unroll
            for (int j = 0; j < 8; ++j) acc[j] = cb[j];
#pragma unroll
            for (int tp = 0; tp < 4; ++tp) { const u32x4 w = xw[k][tp];
                acc[0] += cw[tp][0] * bflo(w.x); acc[1] += cw[tp][1] * bfhi(w.x); acc[2] += cw[tp][2] * bflo(w.y); acc[3] += cw[tp][3] * bfhi(w.y);
                acc[4] += cw[tp][4] * bflo(w.z); acc[5] += cw[tp][5] * bfhi(w.z); acc[6] += cw[tp][6] * bflo(w.w); acc[7] += cw[tp][7] * bfhi(w.w); }
            u32x4 o; o.x = pk2(acc[0], acc[1]); o.y = pk2(acc[2], acc[3]); o.z = pk2(acc[4], acc[5]); o.w = pk2(acc[6], acc[7]);
            *(LAS u32x4*)(lds + L_XC + tok * RS + cg8 * 16) = o;
            if ((cg8 >> 2) == qd) { LAS f32x4* d = (LAS f32x4*)(XCF + tok * 32 + (cg8 & 3) * 8); d[0] = (f32x4){acc[0], acc[1], acc[2], acc[3]}; d[1] = (f32x4){acc[4], acc[5], acc[6], acc[7]}; } }
        if (ci + 1 < SEQ / TC) { LRU_LOAD_X(t0 + TC) }
        __syncthreads();
        f32x4 g[4];
#pragma unroll
        for (int nt = 0; nt < 4; ++nt) g[nt] = (f32x4){0.f, 0.f, 0.f, 0.f};
#pragma unroll
        for (int kk = 0; kk < 4; ++kk) { const bf16x8 a = *(const LAS bf16x8*)(lds + L_XC + (16 * wid + fr) * RS + (kk * 32 + 8 * fq) * 2);
#pragma unroll
            for (int nt = 0; nt < 4; ++nt) { const bf16x8 bb = *(const LAS bf16x8*)(lds + L_WL + (16 * nt + fr) * RS + (kk * 32 + 8 * fq) * 2);
                g[nt] = __builtin_amdgcn_mfma_f32_16x16x32_bf16(a, bb, g[nt], 0, 0, 0); } }
        float Pl[2][4], Hl[2][4], Pe[2], He[2];
#pragma unroll
        for (int t2 = 0; t2 < 2; ++t2) { float P = 1.f, H = 0.f;
#pragma unroll
            for (int rg = 0; rg < 4; ++rg) { const int tok = 16 * wid + 4 * fq + rg, chl = 16 * t2 + fr;
                const float ga = sigmoidf_(g[t2][rg] + ba[t2]), gx = sigmoidf_(g[t2 + 2][rg] + bx[t2]);
                const float la = -ga * sp8[t2]; const float a = __builtin_amdgcn_exp2f(LOG2E * la);
                const float mult = __builtin_amdgcn_sqrtf(fmaxf(1.0f - a * a, 0.f));
                const float u = mult * gx * XCF[tok * 32 + chl];
                H = a * H + u; P = a * P; Pl[t2][rg] = P; Hl[t2][rg] = H; }
            float Pp = __shfl_up(P, 16), Hp = __shfl_up(H, 16); if (fq >= 1) { H = P * Hp + H; P = P * Pp; }
            Pp = __shfl_up(P, 32); Hp = __shfl_up(H, 32); if (fq >= 2) { H = P * Hp + H; P = P * Pp; }
            Pe[t2] = __shfl_up(P, 16); He[t2] = __shfl_up(H, 16); if (fq == 0) { Pe[t2] = 1.f; He[t2] = 0.f; }
            if (fq == 3) { AS[wid * 32 + 16 * t2 + fr] = P; AS[256 + wid * 32 + 16 * t2 + fr] = H; } }
        __syncthreads();
#pragma unroll
        for (int t2 = 0; t2 < 2; ++t2) { float hin = hc[t2], mine = 0.f;
#pragma unroll
            for (int w = 0; w < 8; ++w) { const float P = AS[w * 32 + 16 * t2 + fr], H = AS[256 + w * 32 + 16 * t2 + fr]; if (w == wid) mine = hin; hin = P * hin + H; }
            hc[t2] = hin;
            const float cl = Pe[t2] * mine + He[t2];
#pragma unroll
            for (int rg = 0; rg < 4; ++rg) US[(16 * wid + 4 * fq + rg) * 32 + 16 * t2 + fr] = Hl[t2][rg] + Pl[t2][rg] * cl; }
        __syncthreads();
        { const int tok = tid >> 2, c8 = (tid & 3) * 8; const size_t rowi = (size_t)b * SEQ + t0 + tok;
          const LAS f32x4* hp = (const LAS f32x4*)(US + tok * 32 + c8); const f32x4 h0 = hp[0], h1 = hp[1];
          float y[8] = {bflo(yw.x), bfhi(yw.x), bflo(yw.y), bfhi(yw.y), bflo(yw.z), bfhi(yw.z), bflo(yw.w), bfhi(yw.w)};
          float hv[8] = {h0[0], h0[1], h0[2], h0[3], h1[0], h1[1], h1[2], h1[3]}; float o[8];
#pragma unroll
          for (int j = 0; j < 8; ++j) { const float z = 0.7978845608028654f * (y[j] + 0.044715f * y[j] * y[j] * y[j]); o[j] = hv[j] * y[j] * sigmoidf_(2.0f * z); }
          u32x4 w; w.x = pk2(o[0], o[1]); w.y = pk2(o[2], o[3]); w.z = pk2(o[4], o[5]); w.w = pk2(o[6], o[7]);
          *(u32x4*)(A.merged + rowi * D + n * 128 + 32 * qd + c8) = w; }
    }
    __syncthreads();
}
}

namespace dattn {
constexpr int KVB = 16384, BUFB = 32768, L_SCR = 65536, L_LUT = 65536 + 2048, QROWS = 128;
constexpr float THR = 8.0f;
__device__ __forceinline__ int crow(int r, int hi) { return (r & 3) + 8 * (r >> 2) + 4 * hi; }
__device__ __forceinline__ int swz(int row, int ch) { return 256 * row + 16 * (ch ^ (((row & 3) << 2) | ((row >> 2) & 3))); }
__device__ __forceinline__ s16x4 vtr(const LAS unsigned char* p) { typedef short v4 __attribute__((ext_vector_type(4))); return __builtin_bit_cast(s16x4, __builtin_amdgcn_ds_read_tr16_b64_v4i16((LAS v4*)p)); }
__device__ __forceinline__ unsigned cvtpk(float lo, float hi) { unsigned r; asm volatile("v_cvt_pk_bf16_f32 %0, %1, %2" : "=v"(r) : "v"(lo), "v"(hi)); return r; }
__device__ __forceinline__ void glds16(const void* gsrc, unsigned lds_dst) { unsigned keep;
    asm volatile("s_mov_b32 %0, m0\n\ts_mov_b32 m0, %2\n\ts_nop 0\n\tglobal_load_lds_dwordx4 %1, off\n\ts_mov_b32 m0, %0" : "=&s"(keep) : "v"(gsrc), "s"(lds_dst) : "memory"); }
__device__ __forceinline__ void issue_tile(const bf16* kvb, int t, LAS unsigned char* buf, int wid, int lane) {
#pragma unroll
    for (int i = 0; i < 2; ++i) { const int pc = wid + 8 * i, row = 4 * pc + (lane >> 4), lch = (lane & 15) ^ (((row & 3) << 2) | ((row >> 2) & 3));
        const bf16* g = kvb + (size_t)(64 * t + row) * IN_W + lch * 8;
        const unsigned dst = (unsigned)__builtin_amdgcn_readfirstlane((int)(unsigned)(size_t)(buf + pc * 1024));
        glds16(g + KOFF, dst); glds16(g + VOFF, dst + KVB); }
}
struct Args { const bf16* proj; bf16* merged; const float *rel_bias, *subln_g; float lam; };
__device__ __forceinline__ void unit(const Args& A, LAS unsigned char* lds, int b, int h, int qb) {
    const int tid = threadIdx.x, lane = tid & 63, wid = __builtin_amdgcn_readfirstlane(tid >> 6), r32 = lane & 31, hi = lane >> 5;
    const int rg = wid & 3, c = wid >> 2;
    const int q0 = qb * QROWS, qw = q0 + 32 * rg, qpos = qw + r32;
    const bf16* kvb = A.proj + (size_t)b * SEQ * IN_W + h * 128;
    LAS float* scr = (LAS float*)(lds + L_SCR) + wid * 64;
    LAS float* lut = (LAS float*)(lds + L_LUT);
    if (tid < 128) { int nn = tid; asm volatile("" : "+v"(nn));
        int bk = nn; if (nn >= 16) { bk = 16 + (int)(logf((float)nn * (1.0f / 16.0f)) / 2.0794415416798357f * 16.0f); bk = bk > 31 ? 31 : bk; }
        lut[nn] = A.rel_bias[bk * NH + h] * LOG2E; }
    const int NT = (q0 + QROWS) / 64;
    issue_tile(kvb, 0, lds, wid, lane);
    bf16x8 qf[4];
    { const bf16* qp = A.proj + ((size_t)b * SEQ + qpos) * IN_W + QOFF + h * 128 + c * 64 + hi * 8;
#pragma unroll
      for (int d0 = 0; d0 < 4; ++d0) qf[d0] = *(const bf16x8*)(qp + d0 * 16); }
    int koff[4], voff[2][4];
    { const int x = ((r32 & 3) << 2) | ((r32 >> 2) & 3);
#pragma unroll
      for (int d0 = 0; d0 < 4; ++d0) koff[d0] = 256 * r32 + 16 * ((c * 8 + 2 * d0 + hi) ^ x);
      const int gi = lane & 15, q = gi >> 2, p = gi & 3, chh = (lane >> 4) & 1;
#pragma unroll
      for (int hh = 0; hh < 2; ++hh)
#pragma unroll
          for (int dt = 0; dt < 4; ++dt) voff[hh][dt] = KVB + swz(4 * hi + 8 * hh + q, 4 * dt + 2 * chh + (p >> 1)) + 8 * (p & 1); }
    f32x16 O[4];
#pragma unroll
    for (int dt = 0; dt < 4; ++dt)
#pragma unroll
        for (int r = 0; r < 16; ++r) O[dt][r] = 0.f;
    float m = 0.f, l = 0.f;
    asm volatile("s_waitcnt vmcnt(0)" ::: "memory");
    asm volatile("" : "+v"(qf[0]), "+v"(qf[1]), "+v"(qf[2]), "+v"(qf[3]));
    __syncthreads();
    const float c31 = lut[127];
    f32x16 cinit;
#pragma unroll
    for (int r = 0; r < 16; ++r) cinit[r] = c31;
    asm volatile("" : "+v"(cinit));
    for (int t = 0; t < NT; ++t) {
        const LAS unsigned char* buf = lds + (t & 1) * BUFB;
        if (t + 1 < NT) issue_tile(kvb, t + 1, lds + ((t + 1) & 1) * BUFB, wid, lane);
        if (64 * t <= qw + 31) {
            const bool near = (64 * t + 63 + 113 > qw);
            f32x16 S[2];
#pragma unroll
            for (int nt = 0; nt < 2; ++nt)
#pragma unroll
                for (int d0 = 0; d0 < 4; ++d0) { const bf16x8 kf = *(const LAS bf16x8*)(buf + nt * 8192 + koff[d0]);
                    S[nt] = __builtin_amdgcn_mfma_f32_32x32x16_bf16(kf, qf[d0], d0 == 0 ? cinit : S[nt], 0, 0, 0); }
            if (near) {
                int dbase = qpos - 64 * t - 4 * hi;
                asm volatile("" : "+v"(dbase));
                float bvv[2][16];
#pragma unroll
                for (int nt = 0; nt < 2; ++nt)
#pragma unroll
                    for (int r = 0; r < 16; ++r) { const int dist = dbase - ((r & 3) + 8 * (r >> 2) + 32 * nt); bvv[nt][r] = lut[dist < 0 ? 0 : (dist > 127 ? 127 : dist)] - c31; }
#pragma unroll
                for (int nt = 0; nt < 2; ++nt)
                    asm volatile("" : "+v"(bvv[nt][0]), "+v"(bvv[nt][1]), "+v"(bvv[nt][2]), "+v"(bvv[nt][3]), "+v"(bvv[nt][4]), "+v"(bvv[nt][5]), "+v"(bvv[nt][6]), "+v"(bvv[nt][7]),
                                      "+v"(bvv[nt][8]), "+v"(bvv[nt][9]), "+v"(bvv[nt][10]), "+v"(bvv[nt][11]), "+v"(bvv[nt][12]), "+v"(bvv[nt][13]), "+v"(bvv[nt][14]), "+v"(bvv[nt][15]));
#pragma unroll
                for (int nt = 0; nt < 2; ++nt)
#pragma unroll
                    for (int r = 0; r < 16; ++r) { const int dist = dbase - ((r & 3) + 8 * (r >> 2) + 32 * nt); S[nt][r] = dist >= 0 ? S[nt][r] + bvv[nt][r] : -INFINITY; }
            }
            float rm = S[0][0];
#pragma unroll
            for (int r = 1; r < 16; ++r) rm = fmaxf(rm, S[0][r]);
#pragma unroll
            for (int r = 0; r < 16; ++r) rm = fmaxf(rm, S[1][r]);
            { const auto rr = __builtin_amdgcn_permlane32_swap(__float_as_uint(rm), __float_as_uint(rm), false, false); rm = fmaxf(__uint_as_float(rr[0]), __uint_as_float(rr[1])); }
            if (t == 0 || __any(rm > THR)) {
                const float dl = (t == 0) ? rm : fmaxf(rm, 0.f); m += dl;
#pragma unroll
                for (int nt = 0; nt < 2; ++nt)
#pragma unroll
                    for (int r = 0; r < 16; ++r) S[nt][r] -= dl;
                const float f = __builtin_amdgcn_exp2f(-dl); l *= f;
#pragma unroll
                for (int r = 0; r < 16; ++r) cinit[r] = c31 - m;
                asm volatile("" : "+v"(cinit));
                if (hi == 0) scr[r32] = f;
                asm volatile("s_waitcnt lgkmcnt(0)" ::: "memory");
#pragma unroll
                for (int r = 0; r < 16; ++r) { const float fr_ = scr[crow(r, hi)];
#pragma unroll
                    for (int dt = 0; dt < 4; ++dt) O[dt][r] *= fr_; }
                asm volatile("s_waitcnt lgkmcnt(0)" ::: "memory");
            }
            float sacc = 0.f;
#pragma unroll
            for (int nt = 0; nt < 2; ++nt)
#pragma unroll
                for (int r = 0; r < 16; ++r) { S[nt][r] = __builtin_amdgcn_exp2f(S[nt][r]); sacc += S[nt][r]; }
            l += sacc;
            bf16x8 pw[4];
#pragma unroll
            for (int s = 0; s < 4; ++s) { const int nt = s >> 1, r0 = 8 * (s & 1); u32x4 w;
                w.x = cvtpk(S[nt][r0], S[nt][r0 + 1]); w.y = cvtpk(S[nt][r0 + 2], S[nt][r0 + 3]); w.z = cvtpk(S[nt][r0 + 4], S[nt][r0 + 5]); w.w = cvtpk(S[nt][r0 + 6], S[nt][r0 + 7]);
                pw[s] = __builtin_bit_cast(bf16x8, w); }
            s16x4 vl[2][4], vh[2][4];
#pragma unroll
            for (int dt = 0; dt < 4; ++dt) { vl[0][dt] = vtr(buf + voff[0][dt]); vh[0][dt] = vtr(buf + voff[1][dt]); }
#pragma unroll
            for (int s = 0; s < 4; ++s) {
                if (s < 3) {
#pragma unroll
                    for (int dt = 0; dt < 4; ++dt) { vl[(s + 1) & 1][dt] = vtr(buf + (s + 1) * 4096 + voff[0][dt]); vh[(s + 1) & 1][dt] = vtr(buf + (s + 1) * 4096 + voff[1][dt]); } }
#pragma unroll
                for (int dt = 0; dt < 4; ++dt) { const s16x4 lo = vl[s & 1][dt], hi4 = vh[s & 1][dt];
                    const bf16x8 vf = (bf16x8){lo[0], lo[1], lo[2], lo[3], hi4[0], hi4[1], hi4[2], hi4[3]};
                    O[dt] = __builtin_amdgcn_mfma_f32_32x32x16_bf16(pw[s], vf, O[dt], 0, 0, 0); } }
        }
        asm volatile("s_waitcnt vmcnt(0)" ::: "memory"); __syncthreads();
    }
    l += __shfl_xor(l, 32);
    if (hi == 0) scr[r32] = (c == 0 ? 1.0f : A.lam) / l;
    asm volatile("s_waitcnt lgkmcnt(0)" ::: "memory");
#pragma unroll
    for (int r = 0; r < 16; ++r) { const float i0 = scr[crow(r, hi)];
#pragma unroll
        for (int dt = 0; dt < 4; ++dt) O[dt][r] *= i0; }
    int ln_ = lane; asm volatile("" : "+v"(ln_));
    LAS float* xch = (LAS float*)lds + rg * 4096 + ln_;
    if (c == 1) {
#pragma unroll
        for (int dt = 0; dt < 4; ++dt)
#pragma unroll
            for (int r = 0; r < 16; ++r) xch[(dt * 16 + r) * 64] = O[dt][r];
    }
    __syncthreads();
    if (c == 0) {
        float ss[16];
#pragma unroll
        for (int r = 0; r < 16; ++r) { float s = 0.f;
#pragma unroll
            for (int dt = 0; dt < 4; ++dt) { const float o = O[dt][r] - xch[(dt * 16 + r) * 64]; O[dt][r] = o; s += o * o; }
            ss[r] = s; }
#pragma unroll
        for (int r = 0; r < 16; ++r) { float s = ss[r]; s += __shfl_xor(s, 1); s += __shfl_xor(s, 2); s += __shfl_xor(s, 4); s += __shfl_xor(s, 8); s += __shfl_xor(s, 16);
            ss[r] = (1.0f - LAM_INIT) / sqrtf(s * (1.0f / 128.0f) + LN_EPS); }
#pragma unroll
        for (int dt = 0; dt < 4; ++dt) { const float g = A.subln_g[32 * dt + r32];
#pragma unroll
            for (int r = 0; r < 16; ++r) { const size_t rowi = (size_t)b * SEQ + qw + crow(r, hi);
                A.merged[rowi * D + LRU_W + h * 128 + 32 * dt + r32] = (bf16)f2bf(O[dt][r] * ss[r] * g); } }
    }
    __syncthreads();
}
}

#define RLX_AGENT __ATOMIC_RELAXED, __HIP_MEMORY_SCOPE_AGENT
#define XB_TMO      128
#define XB_XCNT(j)  (256  + 64 * (j))
#define XB_XSUB(j)  (1280 + 64 * (j))
#define XB_XGEN(j)  (2304 + 64 * (j))
#define XB_TOP      3328
#define XB_TOPGEN   3392
#define XCD_BAR_WORDS 3456
#define XB_SPIN_CAP (1u << 18)

__device__ __forceinline__ unsigned xb_ld(unsigned* p)              { return __hip_atomic_load(p, __ATOMIC_RELAXED, __HIP_MEMORY_SCOPE_AGENT); }
__device__ __forceinline__ unsigned xb_add(unsigned* p, unsigned v) { return __hip_atomic_fetch_add(p, v, __ATOMIC_RELAXED, __HIP_MEMORY_SCOPE_AGENT); }
__device__ __forceinline__ unsigned xb_xcc_id() { return (unsigned)__builtin_amdgcn_s_getreg((3 << 11) | 20) & 0xFu; }
#define XB_SPIN(cond, bar) do { unsigned _sp = 0; while (cond) { __builtin_amdgcn_s_sleep(1); \
    if ((++_sp & 255u) == 0u) { if (xb_ld(&(bar)[XB_TMO])) break; if (_sp > XB_SPIN_CAP) { atomicAdd(&(bar)[XB_TMO], 1u); break; } } } } while (0)

struct XcdBarrier {
    unsigned* bar; unsigned x;
    volatile LAS unsigned* st;
};

__device__ __forceinline__ XcdBarrier xcd_barrier_post(unsigned* bar, volatile LAS unsigned* st) {
    XcdBarrier b; b.bar = bar; b.x = xb_xcc_id(); b.st = st;
    if (threadIdx.x == 0) (void)xb_add(&bar[XB_XCNT(b.x)], 1u);
    return b;
}
__device__ __forceinline__ void xcd_barrier_complete(unsigned* bar, unsigned x, unsigned& nloc, unsigned& nx) {
    const unsigned G = gridDim.x * gridDim.y * gridDim.z;
    unsigned sum, cnt, mine, sp = 0u;
    for (;;) {
        sum = 0u; cnt = 0u; mine = 0u;
#pragma unroll
        for (unsigned j = 0; j < 16; ++j) { const unsigned c = xb_ld(&bar[XB_XCNT(j)]); sum += c; cnt += (c > 0u) ? 1u : 0u; mine = (j == x) ? c : mine; }
        if (sum == G) break;
        __builtin_amdgcn_s_sleep(1);
        if ((++sp & 255u) == 0u) { if (xb_ld(&bar[XB_TMO])) break; if (sp > XB_SPIN_CAP) { atomicAdd(&bar[XB_TMO], 1u); break; } }
    }
    nloc = mine > 0u ? mine : 1u; nx = cnt > 0u ? cnt : 1u;
}

__device__ __forceinline__ void xcd_barrier(const XcdBarrier& b) {
    asm volatile("s_waitcnt vmcnt(0)" ::: "memory");
    __syncthreads();
    if (threadIdx.x == 0) {
        unsigned* bar = b.bar;
        __builtin_amdgcn_s_waitcnt(0);
        unsigned nloc = b.st[0], nx = b.st[1];
        if (nloc == 0u) { xcd_barrier_complete(bar, b.x, nloc, nx); b.st[0] = nloc; b.st[1] = nx; }
        const unsigned old = xb_add(&bar[XB_XSUB(b.x)], 1u);
        const unsigned gen = old / nloc;
        if (old + 1u == (gen + 1u) * nloc) {
            __builtin_amdgcn_fence(__ATOMIC_RELEASE, "agent");
            asm volatile("s_waitcnt vmcnt(0)" ::: "memory");
            const unsigned og = xb_add(&bar[XB_TOP], 1u);
            const unsigned tg = og / nx;
            if (og + 1u == (tg + 1u) * nx) xb_add(&bar[XB_TOPGEN], 1u);
            else XB_SPIN(xb_ld(&bar[XB_TOPGEN]) == tg, bar);
            __builtin_amdgcn_fence(__ATOMIC_ACQUIRE, "agent");
            xb_add(&bar[XB_XGEN(b.x)], 1u);
            asm volatile("s_waitcnt vmcnt(0)" ::: "memory");
        } else {
            XB_SPIN(xb_ld(&bar[XB_XGEN(b.x)]) == gen, bar);
            __builtin_amdgcn_fence(__ATOMIC_ACQUIRE, "agent");
            asm volatile("s_waitcnt vmcnt(0)" ::: "memory");
        }
    }
    __syncthreads();
}

constexpr int NPH = 10;
struct Args { const float* in[29]; float* out; unsigned char* ws; int ph_lo, ph_hi; };
__global__ void __launch_bounds__(NWAVES * 64, 2) hymba_fwd(Args args) {
    extern __shared__ __attribute__((aligned(16))) unsigned char lds_raw[];
    LAS unsigned char* lds = (LAS unsigned char*)lds_raw;
    cg::grid_group grid = cg::this_grid();
    const int tid = threadIdx.x, lane = tid & 63, wave = __builtin_amdgcn_readfirstlane(tid >> 6);
    const int G = gridDim.x, bx = blockIdx.x;
    const int gw = bx * NWAVES + wave, NGW = G * NWAVES;
    unsigned char* ws = args.ws;
    typedef __attribute__((address_space(4))) const unsigned long long kconst_t;
    kconst_t* karg = (kconst_t*)__builtin_amdgcn_kernarg_segment_ptr();
#define INP(k) ((const float*)karg[k])
    bf16 *Win = (bf16*)(ws + WS_WIN), *Wout = (bf16*)(ws + WS_WOUT), *Wgu = (bf16*)(ws + WS_WGU), *Wdn = (bf16*)(ws + WS_WDN), *Wpg = (bf16*)(ws + WS_WPG), *Wpp = (bf16*)(ws + WS_WPP), *Wlru = (bf16*)(ws + WS_WLRU);
    bf16 *PB = (bf16*)(ws + WS_PB), *R = (bf16*)(ws + WS_R), *E = (bf16*)(ws + WS_E), *MG = (bf16*)(ws + WS_MG), *XB = (bf16*)(ws + WS_Y);
    bf16* Y = (bf16*)(ws + WS_Y + 128 * MiB);
    const int lo = args.ph_lo, hi = args.ph_hi;
    volatile LAS unsigned* MISC = (volatile LAS unsigned*)(lds + 131072 + 1024);
    if (tid < 16) MISC[tid] = 0u;
    __syncthreads();
    XcdBarrier xbar = xcd_barrier_post((unsigned*)(ws + WS_CTL), MISC + 8);
#define IN(k) (lo <= (k) && (k) < hi)
#define SEAM(k) do { if (IN(k) && IN((k) + 1)) xcd_barrier(xbar); } while (0)
    if (lo > hi) grid.sync();

    if (IN(0)) {
        P0Args A{INP(0), INP(1), INP(2), INP(16), INP(19), INP(20), INP(21), INP(24), INP(26), INP(5), INP(7), Win, Wout, Wgu, Wdn, Wpg, Wpp, Wlru, XB, PB};
        p0_prologue(A, lds, gw, NGW, wave, lane);
    }
    SEAM(0);
    if (IN(1)) {
        { pg8::Gemm g{XB, Win, M, IN_W, D}; pg8::StaticOrder S; S.init(M, IN_W, G, bx); pg8::EpiBf16 Ep{R, IN_W};
          pg8::gemm_phase<pg8::EpiBf16, pg8::StaticOrder, true, true>(lds, g, S, Ep); }
        { pg8::Gemm g{PB, Wpp, M, D, PLE}; pg8::StaticOrder S; S.init(M, D, G, bx); pg8::EpiBf16 Ep{E, D};
          pg8::gemm_phase<pg8::EpiBf16, pg8::StaticOrder, true, true>(lds, g, S, Ep); }
    }
    SEAM(1);
    if (IN(2)) {
        { lru::Args A{R, Wlru, INP(3), INP(4), INP(6), INP(8), INP(9), MG};
          for (int u = bx; u < BATCH * 8 * 4; u += G) lru::unit(A, lds, u); }
        { float d1 = 0.f, d2 = 0.f; { const float a1 = INP(10)[lane] * INP(11)[lane], a2 = INP(12)[lane] * INP(13)[lane]; d1 = wave_sum(a1); d2 = wave_sum(a2); }
          const float lam = __int_as_float(__builtin_amdgcn_readfirstlane(__float_as_int(expf(d1) - expf(d2) + LAM_INIT)));
          dattn::Args A{R, MG, INP(15), INP(14), lam};
          if (G == 256) {
              const int x = bx & 7, k = bx >> 3, s = k & 15;
              for (int j = 0; j < 8; ++j) { const int bh = j * 16 + x * 2 + (k >> 4); dattn::unit(A, lds, bh >> 3, bh & 7, (j & 1) ? s : 15 - s); }
          } else {
              for (int it = bx; it < BATCH * NH * 16; it += G) { const int bh = it >> 4, s = it & 15; dattn::unit(A, lds, bh >> 3, bh & 7, ((it / G) & 1) ? s : 15 - s); }
          } }
    }
    SEAM(2);
    if (IN(3)) {
        pg8::Gemm g{MG, Wout, M, D, D}; pg8::StaticOrder S; S.init(M, D, G, bx); pg8::EpiRes Ep{INP(0), Y, D, ALPHA};
        pg8::gemm_phase<pg8::EpiRes, pg8::StaticOrder, true, true>(lds, g, S, Ep);
    }
    SEAM(3);
    if (IN(4)) ln_rows(Y, INP(17), INP(18), nullptr, MG, gw, NGW, lane);
    SEAM(4);
    if (IN(5)) {
        pg8::Gemm g{MG, Wgu, M, 2 * FFN, D}; pg8::StaticOrder S; S.init(M, 2 * FFN, G, bx); pg8::EpiSwiglu Ep{R, FFN};
        pg8::gemm_phase<pg8::EpiSwiglu, pg8::StaticOrder, true, true>(lds, g, S, Ep);
    }
    SEAM(5);
    if (IN(6)) {
        pg8::Gemm g{R, Wdn, M, D, FFN}; pg8::StaticOrder S; S.init(M, D, G, bx); pg8::EpiResB Ep{MG, Y, ALPHA};
        pg8::gemm_phase<pg8::EpiResB, pg8::StaticOrder, true, true>(lds, g, S, Ep);
    }
    SEAM(6);
    if (IN(7)) ln_rows(Y, INP(22), INP(23), nullptr, MG, gw, NGW, lane);
    SEAM(7);
    if (IN(8)) {
        pg8::Gemm g{MG, Wpg, M, D, D}; pg8::StaticOrder S; S.init(M, D, G, bx); pg8::EpiPleB Ep{MG, E, INP(25), Y, ALPHA};
        pg8::gemm_phase<pg8::EpiPleB, pg8::StaticOrder, true, true>(lds, g, S, Ep);
    }
    SEAM(8);
    if (IN(9)) ln_rows(Y, INP(27), INP(28), args.out, nullptr, gw, NGW, lane);
#undef IN
#undef SEAM
}

#ifndef MK_PER_PHASE
#define MK_PER_PHASE 0
#endif
extern "C" void kernel_launch(void* const* d_in, const int* in_sizes, int n_in, void* d_out, int out_size, void* d_ws, size_t ws_size, hipStream_t stream) {
    static int grid = 0;
    if (grid == 0) {
        if (n_in != 29 || out_size != M * D || ws_size < WS_END) { fprintf(stderr, "kernel_launch: unexpected shapes (n_in %d out %d ws %zu)\n", n_in, out_size, ws_size); grid = -1; return; }
        int dev = 0, cus = 0, per_cu = 0;
        hipGetDevice(&dev); hipDeviceGetAttribute(&cus, hipDeviceAttributeMultiprocessorCount, dev);
        if (hipFuncSetAttribute((const void*)hymba_fwd, hipFuncAttributeMaxDynamicSharedMemorySize, LDS_BYTES) != hipSuccess) { fprintf(stderr, "kernel_launch: hipFuncSetAttribute failed\n"); grid = -1; return; }
        hipOccupancyMaxActiveBlocksPerMultiprocessor(&per_cu, (const void*)hymba_fwd, NWAVES * 64, LDS_BYTES);
        (void)hipGetLastError();
        if (per_cu < 1) fprintf(stderr, "kernel_launch: occupancy query says %d blocks per CU\n", per_cu);
        grid = cus > 0 ? cus : 256;
    }
    if (grid < 0) return;
    Args a{};
    for (int i = 0; i < 29; ++i) a.in[i] = (const float*)d_in[i];
    a.out = (float*)d_out; a.ws = (unsigned char*)d_ws;
#if MK_PER_PHASE
    for (int ph = 0; ph < NPH; ++ph) { a.ph_lo = ph; a.ph_hi = ph + 1; hipLaunchKernelGGL(hymba_fwd, dim3(grid), dim3(NWAVES * 64), LDS_BYTES, stream, a); }
#else
    a.ph_lo = 0; a.ph_hi = NPH;
    if (hipMemsetAsync((char*)d_ws + WS_CTL, 0, CTL_BYTES, stream) != hipSuccess) { fprintf(stderr, "kernel_launch: memset failed\n"); return; }
    void* kargs[] = {&a};
    hipError_t e = hipLaunchCooperativeKernel((const void*)hymba_fwd, dim3(grid), dim3(NWAVES * 64), kargs, LDS_BYTES, stream);
    if (e != hipSuccess) fprintf(stderr, "kernel_launch: cooperative launch failed: %s (grid %d)\n", hipGetErrorString(e), grid);
#endif
}
```

```cpp
#include <hip/hip_runtime.h>
#include <hip/hip_cooperative_groups.h>
#include <cstdio>
#include <cstdint>
namespace cg = cooperative_groups;
namespace pg8 {
#define PG8_LAS __attribute__((address_space(3)))
typedef unsigned short bf16_t;
typedef short bf16x8 __attribute__((ext_vector_type(8)));
typedef float f32x4 __attribute__((ext_vector_type(4)));
typedef unsigned u32x4 __attribute__((ext_vector_type(4)));
constexpr int BM = 256, BK = 64, HALF = 128, HTB = HALF * BK * 2  , STAGE_BYTES = 8 * HTB, NXCD = 8, WGM = 8;

__host__ __device__ __forceinline__ int lds_byte(int r, int c) { const int st = (r >> 4) * 2 + (c >> 5), rr = r & 15, cc = c & 31, ob = rr * 64 + cc * 2; return st * 1024 + (ob ^ (((ob >> 9) & 1) << 5)); }
__host__ __device__ __forceinline__ void stage_rc(int b, int& R, int& C) { const int st = b / 1024, sb = b % 1024, swz = sb ^ (((sb >> 9) & 1) << 5); R = (st >> 1) * 16 + swz / 64; C = (st & 1) * 32 + (swz % 64) / 2; }
__host__ __device__ __forceinline__ int perm32(int rho) { const int n = rho >> 4, i = rho & 15; return 8 * (i >> 2) + 4 * n + (i & 3); }

struct Unit { int pm, pn; };
struct Gemm { const bf16_t* A; const bf16_t* Bt; int M, N, K; };

struct StaticOrder {
    int nM, nN, nwg, G, c;
    __host__ __device__ void init(int M, int N, int G_, int c_) { nM = M / BM; nN = N / BM; nwg = nM * nN; G = G_; c = c_; }
    __host__ __device__ bool next(int i, Unit& u) const {
        const long L = (long)i * G + c; if (L >= nwg) return false;
        int wgid = (int)L; { const int q = nwg / NXCD, r = nwg % NXCD, xcd = wgid % NXCD, off = wgid / NXCD; wgid = (xcd < r ? xcd * (q + 1) : r * (q + 1) + (xcd - r) * q) + off; }
        const int nig = WGM * nN, gid = wgid / nig, fm = gid * WGM, gsz = (nM - fm) < WGM ? (nM - fm) : WGM;
        u.pm = fm + ((wgid % nig) % gsz); u.pn = (wgid % nig) / gsz; return true;
    }
    __device__ __forceinline__ void a_ready(const Unit&) const {}
    __device__ __forceinline__ void done(const Unit&) const {}
};

__device__ __forceinline__ unsigned cvt_pk_bf16(float lo, float hi) { unsigned r; asm volatile("v_cvt_pk_bf16_f32 %0, %1, %2" : "=v"(r) : "v"(lo), "v"(hi)); return r; }
typedef unsigned u32x2 __attribute__((ext_vector_type(2)));
__device__ __forceinline__ float fast_sigmoid(float x) { return __builtin_amdgcn_rcpf(1.0f + __builtin_amdgcn_exp2f(-1.4426950408889634f * x)); }
__device__ __forceinline__ float bf_lo(unsigned w) { return __uint_as_float(w << 16); }
__device__ __forceinline__ float bf_hi(unsigned w) { return __uint_as_float(w & 0xffff0000u); }

struct EpiBf16 {
    static constexpr bool PERM = true, AFTER_DRAIN = false;
    bf16_t* O; int ldc;
    __device__ __forceinline__ void operator()(const f32x4 (&acc)[2][2][4][2], const Unit& u, int wr, int wc, int fr, int fq) const {
        const int row0 = u.pm * BM + wr * 64 + fr; const int col0 = u.pn * BM + wc * 32 + 8 * fq;
#pragma unroll
        for (int ai = 0; ai < 2; ++ai)
#pragma unroll
            for (int m = 0; m < 4; ++m) { bf16_t* rowp = O + (size_t)(row0 + ai * HALF + m * 16) * ldc + col0;
#pragma unroll
                for (int bj = 0; bj < 2; ++bj) { const f32x4 v0 = acc[ai][bj][m][0], v1 = acc[ai][bj][m][1];
                    u32x4 w; w.x = cvt_pk_bf16(v0[0], v0[1]); w.y = cvt_pk_bf16(v0[2], v0[3]); w.z = cvt_pk_bf16(v1[0], v1[1]); w.w = cvt_pk_bf16(v1[2], v1[3]);
                    *(u32x4*)(rowp + bj * HALF) = w; } }
    }
};
struct EpiSwiglu {
    static constexpr bool PERM = true, AFTER_DRAIN = false;
    bf16_t* O; int ldc;
    __device__ __forceinline__ void operator()(const f32x4 (&acc)[2][2][4][2], const Unit& u, int wr, int wc, int fr, int fq) const {
        const int row0 = u.pm * BM + wr * 64 + fr; const int col0 = u.pn * HALF + wc * 32 + 8 * fq;
#pragma unroll
        for (int ai = 0; ai < 2; ++ai)
#pragma unroll
            for (int m = 0; m < 4; ++m) { bf16_t* rowp = O + (size_t)(row0 + ai * HALF + m * 16) * ldc + col0;
                float v[8];
#pragma unroll
                for (int n = 0; n < 2; ++n)
#pragma unroll
                    for (int i = 0; i < 4; ++i) { const float g = acc[ai][0][m][n][i], up = acc[ai][1][m][n][i]; v[n * 4 + i] = g * fast_sigmoid(g) * up; }
                u32x4 w; w.x = cvt_pk_bf16(v[0], v[1]); w.y = cvt_pk_bf16(v[2], v[3]); w.z = cvt_pk_bf16(v[4], v[5]); w.w = cvt_pk_bf16(v[6], v[7]);
                *(u32x4*)rowp = w; }
    }
};
#define PG8_GAS __attribute__((address_space(1)))
struct EpiRes {
    static constexpr bool PERM = true, AFTER_DRAIN = false;
    const float* res; bf16_t* out; int ldc; float alpha;
    __device__ __forceinline__ void operator()(const f32x4 (&acc)[2][2][4][2], const Unit& u, int wr, int wc, int fr, int fq) const {
        const int col0 = u.pn * BM + wc * 32 + 8 * fq; const int rowb = u.pm * BM + wr * 64 + fr;
        const unsigned off0 = (unsigned)(rowb * 2048 + col0);
#define PG8_ROFF(k) (off0 + (unsigned)((((k) >> 2) * HALF + ((k) & 3) * 16) * 2048))
#pragma unroll
        for (int bj = 0; bj < 2; ++bj) { const int c = bj * HALF;
            f32x4 n0 = *(const PG8_GAS f32x4*)(res + PG8_ROFF(0) + c), n1 = *(const PG8_GAS f32x4*)(res + PG8_ROFF(0) + c + 4);
#pragma unroll
            for (int k = 0; k < 8; ++k) { const f32x4 r0 = n0, r1 = n1;
                if (k < 7) { n0 = *(const PG8_GAS f32x4*)(res + PG8_ROFF(k + 1) + c); n1 = *(const PG8_GAS f32x4*)(res + PG8_ROFF(k + 1) + c + 4); }
                const unsigned o = PG8_ROFF(k) + c;
                const f32x4 y0 = r0 * alpha + acc[k >> 2][bj][k & 3][0], y1 = r1 * alpha + acc[k >> 2][bj][k & 3][1];
                u32x4 w; w.x = cvt_pk_bf16(y0[0], y0[1]); w.y = cvt_pk_bf16(y0[2], y0[3]); w.z = cvt_pk_bf16(y1[0], y1[1]); w.w = cvt_pk_bf16(y1[2], y1[3]); *(PG8_GAS u32x4*)(out + o) = w; } }
    }
};
struct EpiPle {
    static constexpr bool PERM = true, AFTER_DRAIN = false;
    const float* res; const bf16_t* e; const float* bias; float* out; int ldc; float alpha;
    __device__ __forceinline__ void operator()(const f32x4 (&acc)[2][2][4][2], const Unit& u, int wr, int wc, int fr, int fq) const {
        const int col0 = u.pn * BM + wc * 32 + 8 * fq; const int rowb = u.pm * BM + wr * 64 + fr;
        const unsigned off0 = (unsigned)(rowb * 2048 + col0);
#pragma unroll
        for (int bj = 0; bj < 2; ++bj) { const int c = bj * HALF;
            const f32x4 b0 = *(const PG8_GAS f32x4*)(bias + col0 + c), b1 = *(const PG8_GAS f32x4*)(bias + col0 + c + 4);
            f32x4 n0 = *(const PG8_GAS f32x4*)(res + PG8_ROFF(0) + c), n1 = *(const PG8_GAS f32x4*)(res + PG8_ROFF(0) + c + 4); u32x4 en = *(const PG8_GAS u32x4*)(e + PG8_ROFF(0) + c);
#pragma unroll
            for (int k = 0; k < 8; ++k) { const f32x4 r0 = n0, r1 = n1; const u32x4 ew = en;
                if (k < 7) { n0 = *(const PG8_GAS f32x4*)(res + PG8_ROFF(k + 1) + c); n1 = *(const PG8_GAS f32x4*)(res + PG8_ROFF(k + 1) + c + 4); en = *(const PG8_GAS u32x4*)(e + PG8_ROFF(k + 1) + c); }
                const f32x4 a0 = acc[k >> 2][bj][k & 3][0] + b0, a1 = acc[k >> 2][bj][k & 3][1] + b1;
                const f32x4 e0 = (f32x4){bf_lo(ew.x), bf_hi(ew.x), bf_lo(ew.y), bf_hi(ew.y)}, e1 = (f32x4){bf_lo(ew.z), bf_hi(ew.z), bf_lo(ew.w), bf_hi(ew.w)};
                f32x4 s0, s1;
#pragma unroll
                for (int i = 0; i < 4; ++i) { s0[i] = fast_sigmoid(a0[i]); s1[i] = fast_sigmoid(a1[i]); }
                const unsigned o = PG8_ROFF(k) + c;
                *(PG8_GAS f32x4*)(out + o) = r0 * alpha + s0 * e0; *(PG8_GAS f32x4*)(out + o + 4) = r1 * alpha + s1 * e1; } }
#undef PG8_ROFF
    }
};

struct EpiResB {
    static constexpr bool PERM = true, AFTER_DRAIN = false;
    const bf16_t* res; bf16_t* out; float alpha;
    __device__ __forceinline__ void operator()(const f32x4 (&acc)[2][2][4][2], const Unit& u, int wr, int wc, int fr, int fq) const {
        const int col0 = u.pn * BM + wc * 32 + 8 * fq; const int rowb = u.pm * BM + wr * 64 + fr;
        const unsigned off0 = (unsigned)(rowb * 2048 + col0);
#define PG8_ROFF(k) (off0 + (unsigned)((((k) >> 2) * HALF + ((k) & 3) * 16) * 2048))
#pragma unroll
        for (int bj = 0; bj < 2; ++bj) { const int c = bj * HALF;
            u32x4 nn = *(const PG8_GAS u32x4*)(res + PG8_ROFF(0) + c);
#pragma unroll
            for (int k = 0; k < 8; ++k) { const u32x4 rw = nn;
                if (k < 7) nn = *(const PG8_GAS u32x4*)(res + PG8_ROFF(k + 1) + c);
                const f32x4 r0 = (f32x4){bf_lo(rw.x), bf_hi(rw.x), bf_lo(rw.y), bf_hi(rw.y)}, r1 = (f32x4){bf_lo(rw.z), bf_hi(rw.z), bf_lo(rw.w), bf_hi(rw.w)};
                const unsigned o = PG8_ROFF(k) + c;
                const f32x4 y0 = r0 * alpha + acc[k >> 2][bj][k & 3][0], y1 = r1 * alpha + acc[k >> 2][bj][k & 3][1];
                u32x4 w; w.x = cvt_pk_bf16(y0[0], y0[1]); w.y = cvt_pk_bf16(y0[2], y0[3]); w.z = cvt_pk_bf16(y1[0], y1[1]); w.w = cvt_pk_bf16(y1[2], y1[3]); *(PG8_GAS u32x4*)(out + o) = w; } }
    }
};
struct EpiPleB {
    static constexpr bool PERM = true, AFTER_DRAIN = false;
    const bf16_t* res; const bf16_t* e; const float* bias; bf16_t* out; float alpha;
    __device__ __forceinline__ void operator()(const f32x4 (&acc)[2][2][4][2], const Unit& u, int wr, int wc, int fr, int fq) const {
        const int col0 = u.pn * BM + wc * 32 + 8 * fq; const int rowb = u.pm * BM + wr * 64 + fr;
        const unsigned off0 = (unsigned)(rowb * 2048 + col0);
#pragma unroll
        for (int bj = 0; bj < 2; ++bj) { const int c = bj * HALF;
            const f32x4 b0 = *(const PG8_GAS f32x4*)(bias + col0 + c), b1 = *(const PG8_GAS f32x4*)(bias + col0 + c + 4);
            u32x4 nn = *(const PG8_GAS u32x4*)(res + PG8_ROFF(0) + c), en = *(const PG8_GAS u32x4*)(e + PG8_ROFF(0) + c);
#pragma unroll
            for (int k = 0; k < 8; ++k) { const u32x4 rw = nn, ew = en;
                if (k < 7) { nn = *(const PG8_GAS u32x4*)(res + PG8_ROFF(k + 1) + c); en = *(const PG8_GAS u32x4*)(e + PG8_ROFF(k + 1) + c); }
                const f32x4 r0 = (f32x4){bf_lo(rw.x), bf_hi(rw.x), bf_lo(rw.y), bf_hi(rw.y)}, r1 = (f32x4){bf_lo(rw.z), bf_hi(rw.z), bf_lo(rw.w), bf_hi(rw.w)};
                const f32x4 a0 = acc[k >> 2][bj][k & 3][0] + b0, a1 = acc[k >> 2][bj][k & 3][1] + b1;
                const f32x4 e0 = (f32x4){bf_lo(ew.x), bf_hi(ew.x), bf_lo(ew.y), bf_hi(ew.y)}, e1 = (f32x4){bf_lo(ew.z), bf_hi(ew.z), bf_lo(ew.w), bf_hi(ew.w)};
                f32x4 s0, s1;
#pragma unroll
                for (int i = 0; i < 4; ++i) { s0[i] = fast_sigmoid(a0[i]); s1[i] = fast_sigmoid(a1[i]); }
                const unsigned o = PG8_ROFF(k) + c;
                const f32x4 y0 = r0 * alpha + s0 * e0, y1 = r1 * alpha + s1 * e1;
                u32x4 w; w.x = cvt_pk_bf16(y0[0], y0[1]); w.y = cvt_pk_bf16(y0[2], y0[3]); w.z = cvt_pk_bf16(y1[0], y1[1]); w.w = cvt_pk_bf16(y1[2], y1[3]); *(PG8_GAS u32x4*)(out + o) = w; } }
#undef PG8_ROFF
    }
};
template <class Epi, class Sched, bool ALIGN_EPI = false, bool SP2 = false>
__device__ __forceinline__ void gemm_phase(PG8_LAS unsigned char* lds, const Gemm g, const Sched& S, const Epi& E) {
    const int tid = threadIdx.x, wid = __builtin_amdgcn_readfirstlane(tid >> 6), lane = tid & 63, wr = wid >> 2, wc = wid & 3, fr = lane & 15, fq = lane >> 4;
    const int K = g.K, nt = K / BK;
    unsigned voffA[2], voffB[2];
#pragma unroll
    for (int i = 0; i < 2; ++i) { int R, C; stage_rc(tid * 16 + i * 8192, R, C); const int Rb = Epi::PERM ? ((R & ~31) + perm32(R & 31)) : R;
        voffA[i] = (unsigned)(R * K + C) * 2u; voffB[i] = (unsigned)(Rb * K + C) * 2u; }
    const size_t kstep = (size_t)(BK * 2);
    const size_t hstep = (size_t)HALF * K * 2;
    const size_t tstep = 2 * hstep;
    const unsigned ldsw = (unsigned)wid * 1024u;
    const int aoff = lds_byte(wr * 64 + fr, fq * 8), boff = lds_byte(wc * 32 + fr, fq * 8);
#define PG8_SA(b, h) (((b) * 2 + (h)) * HTB)
#define PG8_SB(b, h) ((4 + (b) * 2 + (h)) * HTB)
#define PG8_STAGE(bufoff, gbase, voff) do { _Pragma("unroll") for (int _i = 0; _i < 2; ++_i) \
        __builtin_amdgcn_global_load_lds((const unsigned*)((const char*)(gbase) + (voff)[_i]), (PG8_LAS unsigned*)(lds + (bufoff) + ldsw + _i * 8192), 16, 0, 0); } while (0)
#define PG8_LDA(dst, b, h) do { _Pragma("unroll") for (int m = 0; m < 4; ++m) _Pragma("unroll") for (int k = 0; k < 2; ++k) dst[m][k] = *(const PG8_LAS bf16x8*)(lds + PG8_SA(b, h) + aoff + m * 2048 + k * 1024); } while (0)
#define PG8_LDB(dst, b, h) do { _Pragma("unroll") for (int n = 0; n < 2; ++n) _Pragma("unroll") for (int k = 0; k < 2; ++k) dst[n][k] = *(const PG8_LAS bf16x8*)(lds + PG8_SB(b, h) + boff + n * 2048 + k * 1024); } while (0)
#define PG8_MMA(ai, bj, At, Bt) do { __builtin_amdgcn_s_setprio(1); _Pragma("unroll") for (int m = 0; m < 4; ++m) _Pragma("unroll") for (int n = 0; n < 2; ++n) _Pragma("unroll") for (int k = 0; k < 2; ++k) \
        acc[ai][bj][m][n] = __builtin_amdgcn_mfma_f32_16x16x32_bf16(Bt[n][k], At[m][k], acc[ai][bj][m][n], 0, 0, 0); __builtin_amdgcn_s_setprio(0); } while (0)
#define PG8_WAIT_V(n) asm volatile("s_waitcnt vmcnt(" #n ")" ::: "memory")
#define PG8_WAIT_L(n) asm volatile("s_waitcnt lgkmcnt(" #n ")" ::: "memory")
#define PG8_BAR __builtin_amdgcn_s_barrier()
#define PG8_SCHED __builtin_amdgcn_sched_barrier(0)
    Unit cur, nxt; int ui = 0;
    if (!S.next(0, cur)) return;
    f32x4 acc[2][2][4][2];
#pragma unroll
    for (int a = 0; a < 2; ++a)
#pragma unroll
        for (int b = 0; b < 2; ++b)
#pragma unroll
            for (int m = 0; m < 4; ++m)
#pragma unroll
                for (int n = 0; n < 2; ++n) acc[a][b][m][n] = (f32x4){0.f, 0.f, 0.f, 0.f};
    bf16x8 At[4][2], B0[2][2], B1[2][2];
    const char* cA = (const char*)g.A + (size_t)cur.pm * tstep; const char* cB = (const char*)g.Bt + (size_t)cur.pn * tstep;
    S.a_ready(cur);
    if constexpr (SP2) {
        PG8_STAGE(PG8_SB(0, 0), cB, voffB); PG8_STAGE(PG8_SB(0, 1), cB + hstep, voffB); PG8_STAGE(PG8_SA(0, 0), cA, voffA); PG8_STAGE(PG8_SA(0, 1), cA + hstep, voffA);
        if (wr == 1) PG8_BAR;
        PG8_WAIT_V(2); PG8_BAR;
        PG8_STAGE(PG8_SB(1, 0), cB + kstep, voffB); PG8_STAGE(PG8_SA(1, 0), cA + kstep, voffA); PG8_STAGE(PG8_SB(1, 1), cB + hstep + kstep, voffB);
        PG8_WAIT_V(6); PG8_BAR;
    } else {
        PG8_STAGE(PG8_SB(0, 0), cB, voffB); PG8_STAGE(PG8_SA(0, 0), cA, voffA); PG8_STAGE(PG8_SB(0, 1), cB + hstep, voffB); PG8_STAGE(PG8_SA(0, 1), cA + hstep, voffA);
        if (wr == 1) PG8_BAR;
        PG8_WAIT_V(4); PG8_BAR;
        PG8_STAGE(PG8_SB(1, 0), cB + kstep, voffB); PG8_STAGE(PG8_SA(1, 0), cA + kstep, voffA); PG8_STAGE(PG8_SB(1, 1), cB + hstep + kstep, voffB);
        PG8_WAIT_V(6); PG8_BAR;
    }
    for (;;) {
        const bool has_next = S.next(ui + 1, nxt);
        const char* nA = has_next ? (const char*)g.A + (size_t)nxt.pm * tstep : cA; const char* nB = has_next ? (const char*)g.Bt + (size_t)nxt.pn * tstep : cB;
        for (int t = 0; t < nt; t += 2) {
            const bool last = (t == nt - 2);
            const char* a1 = cA + (size_t)(t + 1) * kstep;
            const char* a2 = last ? nA : cA + (size_t)(t + 2) * kstep; const char* b2 = last ? nB : cB + (size_t)(t + 2) * kstep;
            const char* a3 = a2 + kstep; const char* b3 = b2 + kstep;
            if (last && has_next) S.a_ready(nxt);
            if constexpr (SP2) {
            PG8_LDB(B0, 0, 0); PG8_LDB(B1, 0, 1); PG8_SCHED; PG8_LDA(At, 0, 0); PG8_STAGE(PG8_SA(1, 1), a1 + hstep, voffA);
            PG8_WAIT_V(8); PG8_WAIT_L(0); PG8_BAR; PG8_MMA(0, 0, At, B0); PG8_MMA(0, 1, At, B1); PG8_BAR; PG8_SCHED;
            PG8_LDA(At, 0, 1); PG8_STAGE(PG8_SB(0, 0), b2, voffB); PG8_STAGE(PG8_SB(0, 1), b2 + hstep, voffB); PG8_STAGE(PG8_SA(0, 0), a2, voffA);
            PG8_WAIT_V(8); PG8_WAIT_L(0); PG8_BAR; PG8_MMA(1, 0, At, B0); PG8_MMA(1, 1, At, B1); PG8_BAR; PG8_SCHED;
            PG8_LDB(B0, 1, 0); PG8_LDB(B1, 1, 1); PG8_SCHED; PG8_LDA(At, 1, 0); PG8_STAGE(PG8_SA(0, 1), a2 + hstep, voffA);
            PG8_WAIT_V(8); PG8_WAIT_L(0); PG8_BAR; PG8_MMA(0, 0, At, B0); PG8_MMA(0, 1, At, B1); PG8_BAR; PG8_SCHED;
            PG8_LDA(At, 1, 1); PG8_STAGE(PG8_SB(1, 0), b3, voffB); PG8_STAGE(PG8_SB(1, 1), b3 + hstep, voffB); PG8_STAGE(PG8_SA(1, 0), a3, voffA);
            PG8_WAIT_V(8); PG8_WAIT_L(0); PG8_BAR; PG8_MMA(1, 0, At, B0); PG8_MMA(1, 1, At, B1); PG8_BAR; PG8_SCHED;
            } else {
            PG8_LDB(B0, 0, 0); PG8_SCHED; PG8_LDA(At, 0, 0); PG8_STAGE(PG8_SA(1, 1), a1 + hstep, voffA);
            PG8_WAIT_L(8); PG8_BAR; PG8_WAIT_L(0); PG8_MMA(0, 0, At, B0); PG8_BAR; PG8_SCHED;
            PG8_LDB(B1, 0, 1); PG8_STAGE(PG8_SB(0, 0), b2, voffB);
            PG8_BAR; PG8_WAIT_L(0); PG8_MMA(0, 1, At, B1); PG8_BAR;
            PG8_LDA(At, 0, 1); PG8_STAGE(PG8_SA(0, 0), a2, voffA);
            PG8_BAR; PG8_WAIT_L(0); PG8_MMA(1, 0, At, B0); PG8_BAR; PG8_SCHED;
            PG8_STAGE(PG8_SB(0, 1), b2 + hstep, voffB);
            PG8_WAIT_V(6); PG8_BAR; PG8_MMA(1, 1, At, B1); PG8_BAR;
            PG8_LDB(B0, 1, 0); PG8_SCHED; PG8_LDA(At, 1, 0); PG8_STAGE(PG8_SA(0, 1), a2 + hstep, voffA);
            PG8_WAIT_L(8); PG8_BAR; PG8_WAIT_L(0); PG8_MMA(0, 0, At, B0); PG8_BAR; PG8_SCHED;
            PG8_LDB(B1, 1, 1); PG8_STAGE(PG8_SB(1, 0), b3, voffB);
            PG8_BAR; PG8_WAIT_L(0); PG8_MMA(0, 1, At, B1); PG8_BAR;
            PG8_LDA(At, 1, 1); PG8_STAGE(PG8_SA(1, 0), a3, voffA);
            PG8_BAR; PG8_WAIT_L(0); PG8_MMA(1, 0, At, B0); PG8_BAR; PG8_SCHED;
            PG8_STAGE(PG8_SB(1, 1), b3 + hstep, voffB);
            PG8_WAIT_V(6); PG8_BAR; PG8_MMA(1, 1, At, B1); PG8_BAR;
            }
        }
        if constexpr (ALIGN_EPI) { if (wr == 0) PG8_BAR; }
        if constexpr (!Epi::AFTER_DRAIN) { E(acc, cur, wr, wc, fr, fq); S.done(cur); }
        if (!has_next) break;
#pragma unroll
        for (int a = 0; a < 2; ++a)
#pragma unroll
            for (int b = 0; b < 2; ++b)
#pragma unroll
                for (int m = 0; m < 4; ++m)
#pragma unroll
                    for (int n = 0; n < 2; ++n) acc[a][b][m][n] = (f32x4){0.f, 0.f, 0.f, 0.f};
        cur = nxt; cA = nA; cB = nB; ++ui;
        if constexpr (ALIGN_EPI) { if (wr == 1) PG8_BAR; }
    }
    PG8_WAIT_V(0);
    if constexpr (!ALIGN_EPI) { if (wr == 0) PG8_BAR; }
    PG8_BAR;
    if constexpr (Epi::AFTER_DRAIN) { E.fused(acc, cur, wr, wc, fr, fq, lds, wid, lane); S.done(cur); }
#undef PG8_SA
#undef PG8_SB
#undef PG8_STAGE
#undef PG8_LDA
#undef PG8_LDB
#undef PG8_MMA
#undef PG8_WAIT_V
#undef PG8_WAIT_L
#undef PG8_BAR
#undef PG8_SCHED
}
}

#define LAS __attribute__((address_space(3)))
typedef unsigned short bf16;
typedef unsigned u32x4 __attribute__((ext_vector_type(4)));
typedef unsigned u32x2 __attribute__((ext_vector_type(2)));
typedef float f32x4 __attribute__((ext_vector_type(4)));
typedef float f32x16 __attribute__((ext_vector_type(16)));
typedef short bf16x8 __attribute__((ext_vector_type(8)));
typedef short s16x4 __attribute__((ext_vector_type(4)));

constexpr int NWAVES = 8;
constexpr int BATCH = 16, SEQ = 2048, D = 2048, M = BATCH * SEQ;
constexpr int LRU_W = 1024, IN_W = 5120, FFN = 5632, PLE = 256, NH = 8;
constexpr int QOFF = 2048, KOFF = 3072, VOFF = 4096;
constexpr float LN_EPS = 1e-5f;
constexpr float ALPHA = 1.189207115002721f;
constexpr float LAM_INIT = 0.2f;
constexpr float LOG2E = 1.4426950408889634f;
constexpr float QSCALE = 0.125f * LOG2E;

constexpr size_t MiB = 1u << 20;
constexpr size_t WS_WIN = 0, WS_WOUT = 20 * MiB, WS_WGU = 28 * MiB, WS_WDN = 72 * MiB, WS_WPG = 94 * MiB, WS_WPP = 102 * MiB, WS_WLRU = 103 * MiB;
constexpr size_t WS_PB = 104 * MiB;
constexpr size_t WS_R = 120 * MiB;
constexpr size_t WS_E = 472 * MiB;
constexpr size_t WS_MG = 600 * MiB;
constexpr size_t WS_Y = 728 * MiB;
constexpr size_t WS_CTL = 984 * MiB, CTL_BYTES = 16384;
constexpr size_t WS_END = 985 * MiB;

constexpr int LDS_BYTES = 131072 + 4096;

__device__ __forceinline__ unsigned f2bf(float f) { unsigned u = __builtin_bit_cast(unsigned, f); return (u + 0x7fffu + ((u >> 16) & 1u)) >> 16; }
__device__ __forceinline__ unsigned pk2(float lo, float hi) { return f2bf(lo) | (f2bf(hi) << 16); }
__device__ __forceinline__ float bflo(unsigned w) { return __uint_as_float(w << 16); }
__device__ __forceinline__ float bfhi(unsigned w) { return __uint_as_float(w & 0xffff0000u); }
__device__ __forceinline__ float wave_sum(float v) {
#pragma unroll
    for (int o = 1; o < 64; o <<= 1) v += __shfl_xor(v, o);
    return v;
}
__device__ __forceinline__ float sigmoidf_(float x) { return __builtin_amdgcn_rcpf(1.0f + __builtin_amdgcn_exp2f(-LOG2E * x)); }

__device__ __forceinline__ void tr_item(const float* W, int ldw, int k0, int n0, bf16* WT, size_t drow0, int ldk, float scale, LAS float* scr, int lane) {
    float wv[32];
#pragma unroll
    for (int i = 0; i < 32; ++i) wv[i] = W[(size_t)(k0 + 2 * i + (lane >> 5)) * ldw + n0 + (lane & 31)];
#pragma unroll
    for (int i = 0; i < 32; ++i) scr[(2 * i + (lane >> 5)) * 33 + (lane & 31)] = wv[i];
    asm volatile("s_waitcnt lgkmcnt(0)" ::: "memory");
    const int c = lane & 7;
#pragma unroll
    for (int j = 0; j < 4; ++j) { const int n = (lane >> 3) + 8 * j; const LAS float* s = scr + (8 * c) * 33 + n;
        u32x4 o; o.x = pk2(s[0 * 33] * scale, s[1 * 33] * scale); o.y = pk2(s[2 * 33] * scale, s[3 * 33] * scale); o.z = pk2(s[4 * 33] * scale, s[5 * 33] * scale); o.w = pk2(s[6 * 33] * scale, s[7 * 33] * scale);
        *(u32x4*)(WT + (drow0 + n) * ldk + k0 + 8 * c) = o; }
    asm volatile("s_waitcnt lgkmcnt(0)" ::: "memory");
}
struct P0Args { const float *x, *p, *w_in, *w_out, *w_gate, *w_up, *w_down, *w_pg, *w_pp, *lru_wa, *lru_wx; bf16 *Win, *Wout, *Wgu, *Wdn, *Wpg, *Wpp, *Wlru, *xb, *pb; };
__device__ __forceinline__ void p0_prologue(const P0Args& A, LAS unsigned char* lds, int gw, int NGW, int wave, int lane) {
    LAS float* scr = (LAS float*)(lds + wave * 8448);
    constexpr int I_IN = (D / 64) * (IN_W / 32), I_OUT = (D / 64) * (D / 32), I_G = (D / 64) * (FFN / 32), I_DN = (FFN / 64) * (D / 32), I_PG = I_OUT, I_PP = (PLE / 64) * (D / 32), I_L = 8 * 2 * 4;
    constexpr int NITEMS = I_IN + I_OUT + 2 * I_G + I_DN + I_PG + I_PP + 2 * I_L;
    const size_t gt = (size_t)gw * 64 + lane, NT = (size_t)NGW * 64;
#pragma unroll 4
    for (size_t i = gt; i < (size_t)M * D / 8; i += NT) { const f32x4 a = *(const f32x4*)(A.x + i * 8), b = *(const f32x4*)(A.x + i * 8 + 4);
        u32x4 o; o.x = pk2(a[0], a[1]); o.y = pk2(a[2], a[3]); o.z = pk2(b[0], b[1]); o.w = pk2(b[2], b[3]); *(u32x4*)(A.xb + i * 8) = o; }
#pragma unroll 4
    for (size_t i = gt; i < (size_t)M * PLE / 8; i += NT) { const f32x4 a = *(const f32x4*)(A.p + i * 8), b = *(const f32x4*)(A.p + i * 8 + 4);
        u32x4 o; o.x = pk2(a[0], a[1]); o.y = pk2(a[2], a[3]); o.z = pk2(b[0], b[1]); o.w = pk2(b[2], b[3]); *(u32x4*)(A.pb + i * 8) = o; }
    for (int it = gw; it < NITEMS; it += NGW) {
        int r = it;
        if (r < I_IN) { const int nb = IN_W / 32, k0 = 64 * (r / nb), n0 = 32 * (r % nb); tr_item(A.w_in, IN_W, k0, n0, A.Win, n0, D, (n0 >= QOFF && n0 < KOFF) ? QSCALE : 1.f, scr, lane); continue; } r -= I_IN;
        if (r < I_OUT) { const int nb = D / 32, k0 = 64 * (r / nb), n0 = 32 * (r % nb); tr_item(A.w_out, D, k0, n0, A.Wout, n0, D, 1.f, scr, lane); continue; } r -= I_OUT;
        if (r < 2 * I_G) { const int up = r >= I_G; if (up) r -= I_G; const int nb = FFN / 32, k0 = 64 * (r / nb), n0 = 32 * (r % nb);
            tr_item(up ? A.w_up : A.w_gate, FFN, k0, n0, A.Wgu, (size_t)(n0 / 128) * 256 + (n0 % 128) + (up ? 128 : 0), D, 1.f, scr, lane); continue; } r -= 2 * I_G;
        if (r < I_DN) { const int nb = D / 32, k0 = 64 * (r / nb), n0 = 32 * (r % nb); tr_item(A.w_down, D, k0, n0, A.Wdn, n0, FFN, 1.f, scr, lane); continue; } r -= I_DN;
        if (r < I_PG) { const int nb = D / 32, k0 = 64 * (r / nb), n0 = 32 * (r % nb); tr_item(A.w_pg, D, k0, n0, A.Wpg, n0, D, 1.f, scr, lane); continue; } r -= I_PG;
        if (r < I_PP) { const int nb = D / 32, k0 = 64 * (r / nb), n0 = 32 * (r % nb); tr_item(A.w_pp, D, k0, n0, A.Wpp, n0, PLE, 1.f, scr, lane); continue; } r -= I_PP;
        { const int isx = r >= I_L; if (isx) r -= I_L; const int n = r >> 3, k0 = 64 * ((r >> 2) & 1), n0 = 32 * (r & 3);
          tr_item((isx ? A.lru_wx : A.lru_wa) + (size_t)n * 128 * 128, 128, k0, n0, A.Wlru + (size_t)n * 256 * 128, n0 + (isx ? 128 : 0), 128, 1.f, scr, lane); }
    }
}

__device__ __forceinline__ void ln_rows(const bf16* Yb, const float* g, const float* bt, float* outf, bf16* outb, int gw, int NGW, int lane) {
    u32x4 nx[4];
    if (gw < M) { const u32x4* yr = (const u32x4*)(Yb + (size_t)gw * D) + lane;
#pragma unroll
        for (int j = 0; j < 4; ++j) nx[j] = yr[64 * j]; }
    for (int row = gw; row < M; row += NGW) {
        float v[4][8]; float s = 0.f;
#pragma unroll
        for (int j = 0; j < 4; ++j) { const u32x4 w = nx[j]; v[j][0] = bflo(w.x); v[j][1] = bfhi(w.x); v[j][2] = bflo(w.y); v[j][3] = bfhi(w.y); v[j][4] = bflo(w.z); v[j][5] = bfhi(w.z); v[j][6] = bflo(w.w); v[j][7] = bfhi(w.w);
            s += ((v[j][0] + v[j][1]) + (v[j][2] + v[j][3])) + ((v[j][4] + v[j][5]) + (v[j][6] + v[j][7])); }
        if (row + NGW < M) { const u32x4* yr = (const u32x4*)(Yb + (size_t)(row + NGW) * D) + lane;
#pragma unroll
            for (int j = 0; j < 4; ++j) nx[j] = yr[64 * j]; }
        const float mean = wave_sum(s) * (1.f / D); float s2 = 0.f;
#pragma unroll
        for (int j = 0; j < 4; ++j)
#pragma unroll
            for (int i = 0; i < 8; ++i) { v[j][i] -= mean; s2 += v[j][i] * v[j][i]; }
        const float rstd = 1.f / sqrtf(wave_sum(s2) * (1.f / D) + LN_EPS);
#pragma unroll
        for (int j = 0; j < 4; ++j) { const int col = 8 * (lane + 64 * j);
            const f32x4 g0 = *(const f32x4*)(g + col), g1 = *(const f32x4*)(g + col + 4), b0 = *(const f32x4*)(bt + col), b1 = *(const f32x4*)(bt + col + 4);
            const f32x4 o0 = (f32x4){v[j][0], v[j][1], v[j][2], v[j][3]} * rstd * g0 + b0, o1 = (f32x4){v[j][4], v[j][5], v[j][6], v[j][7]} * rstd * g1 + b1;
            if (outf) { *(f32x4*)(outf + (size_t)row * D + col) = o0; *(f32x4*)(outf + (size_t)row * D + col + 4) = o1; }
            if (outb) { u32x4 w; w.x = pk2(o0[0], o0[1]); w.y = pk2(o0[2], o0[3]); w.z = pk2(o1[0], o1[1]); w.w = pk2(o1[2], o1[3]); *(u32x4*)(outb + (size_t)row * D + col) = w; } }
    }
}

namespace lru {
__device__ __forceinline__ float nexpm1(float x) { const float p = -x * (1.0f + x * (0.5f + x * (0.16666667f + x * (0.041666668f + x * (0.0083333338f + x * 0.0013888889f)))));
    const float d = 1.0f - __builtin_amdgcn_exp2f(LOG2E * x); return x > -0.25f ? p : d; }
constexpr int TC = 128, RS = 272;
constexpr int L_XC = 0, L_WL = L_XC + TC * RS, L_XCF = L_WL + 64 * RS, L_AS = L_XCF + TC * 32 * 4, L_US = L_AS + TC * 32 * 4, L_END = L_US + TC * 32 * 4;
static_assert(L_END <= 131072, "lru lds");
struct Args { const bf16* proj; const bf16* Wlru; const float *conv_w, *conv_b, *ba, *bx, *lam; bf16* merged; };
__device__ __forceinline__ void unit(const Args& A, LAS unsigned char* lds, int un) {
    const int tid = threadIdx.x, lane = tid & 63, wid = __builtin_amdgcn_readfirstlane(tid >> 6), fr = lane & 15, fq = lane >> 4;
    const int b = un >> 5, n = (un >> 2) & 7, qd = un & 3;
    LAS float* XCF = (LAS float*)(lds + L_XCF); LAS float* AS = (LAS float*)(lds + L_AS); LAS float* US = (LAS float*)(lds + L_US);
#pragma unroll
    for (int i = 0; i < 2; ++i) { const int idx = tid + 512 * i, row = idx >> 4, ch = idx & 15; const int srow = n * 256 + (row < 32 ? 32 * qd + row : 128 + 32 * qd + row - 32);
        *(LAS u32x4*)(lds + L_WL + row * RS + ch * 16) = *(const u32x4*)(A.Wlru + (size_t)srow * 128 + ch * 8); }
    float ba[2], bx[2], sp8[2];
#pragma unroll
    for (int t2 = 0; t2 < 2; ++t2) { const int ch = n * 128 + 32 * qd + 16 * t2 + fr; ba[t2] = A.ba[ch]; bx[t2] = A.bx[ch];
        const float L = A.lam[ch]; sp8[t2] = 8.0f * (fmaxf(-L, 0.f) + log1pf(expf(-fabsf(L)))); }
    const int cg8 = tid & 15;
    float cw[4][8], cb[8];
#pragma unroll
    for (int j = 0; j < 8; ++j) { const int ch = n * 128 + cg8 * 8 + j; cb[j] = A.conv_b[ch];
#pragma unroll
        for (int t = 0; t < 4; ++t) cw[t][j] = A.conv_w[t * LRU_W + ch]; }
    float hc[2] = {0.f, 0.f};
    const bf16* xbase = A.proj + (size_t)b * SEQ * IN_W + n * 128 + cg8 * 8;
    u32x4 xw[4][4];
#define LRU_LOAD_X(T0) _Pragma("unroll") for (int k = 0; k < 4; ++k) _Pragma("unroll") for (int tp = 0; tp < 4; ++tp) { const int tt = (T0) + (tid >> 4) + 32 * k - 3 + tp; \
        xw[k][tp] = tt >= 0 ? *(const u32x4*)(xbase + (size_t)tt * IN_W) : (u32x4){0u, 0u, 0u, 0u}; }
    LRU_LOAD_X(0)
    for (int ci = 0; ci < SEQ / TC; ++ci) {
        const int t0 = ci * TC;
        const u32x4 yw = *(const u32x4*)(A.proj + ((size_t)b * SEQ + t0 + (tid >> 2)) * IN_W + LRU_W + n * 128 + 32 * qd + (tid & 3) * 8);
#pragma unroll
        for (int k = 0; k < 4; ++k) { const int tok = (tid >> 4) + 32 * k;
            float acc[8];
#pragma unroll
            for (int j = 0; j < 8; ++j) acc[j] = cb[j];
#pragma unroll
            for (int tp = 0; tp < 4; ++tp) { const u32x4 w = xw[k][tp];
                acc[0] += cw[tp][0] * bflo(w.x); acc[1] += cw[tp][1] * bfhi(w.x); acc[2] += cw[tp][2] * bflo(w.y); acc[3] += cw[tp][3] * bfhi(w.y);
                acc[4] += cw[tp][4] * bflo(w.z); acc[5] += cw[tp][5] * bfhi(w.z); acc[6] += cw[tp][6] * bflo(w.w); acc[7] += cw[tp][7] * bfhi(w.w); }
            u32x4 o; o.x = pk2(acc[0], acc[1]); o.y = pk2(acc[2], acc[3]); o.z = pk2(acc[4], acc[5]); o.w = pk2(acc[6], acc[7]);
            *(LAS u32x4*)(lds + L_XC + tok * RS + cg8 * 16) = o;
            if ((cg8 >> 2) == qd) { LAS f32x4* d = (LAS f32x4*)(XCF + tok * 32 + (cg8 & 3) * 8); d[0] = (f32x4){acc[0], acc[1], acc[2], acc[3]}; d[1] = (f32x4){acc[4], acc[5], acc[6], acc[7]}; } }
        if (ci + 1 < SEQ / TC) { LRU_LOAD_X(t0 + TC) }
        __syncthreads();
        f32x4 g[4];
#pragma unroll
        for (int nt = 0; nt < 4; ++nt) g[nt] = (f32x4){0.f, 0.f, 0.f, 0.f};
#pragma unroll
        for (int kk = 0; kk < 4; ++kk) { const bf16x8 a = *(const LAS bf16x8*)(lds + L_XC + (16 * wid + fr) * RS + (kk * 32 + 8 * fq) * 2);
#pragma unroll
            for (int nt = 0; nt < 4; ++nt) { const bf16x8 bb = *(const LAS bf16x8*)(lds + L_WL + (16 * nt + fr) * RS + (kk * 32 + 8 * fq) * 2);
                g[nt] = __builtin_amdgcn_mfma_f32_16x16x32_bf16(a, bb, g[nt], 0, 0, 0); } }
        float Pl[2][4], Hl[2][4], Pe[2], He[2];
#pragma unroll
        for (int t2 = 0; t2 < 2; ++t2) { float P = 1.f, H = 0.f;
#pragma unroll
            for (int rg = 0; rg < 4; ++rg) { const int tok = 16 * wid + 4 * fq + rg, chl = 16 * t2 + fr;
                const float ga = sigmoidf_(g[t2][rg] + ba[t2]), gx = sigmoidf_(g[t2 + 2][rg] + bx[t2]);
                const float la = -ga * sp8[t2]; const float a = __builtin_amdgcn_exp2f(LOG2E * la);
                const float mult = __builtin_amdgcn_sqrtf(nexpm1(2.0f * la));
                const float u = mult * gx * XCF[tok * 32 + chl];
                H = a * H + u; P = a * P; Pl[t2][rg] = P; Hl[t2][rg] = H; }
            float Pp = __shfl_up(P, 16), Hp = __shfl_up(H, 16); if (fq >= 1) { H = P * Hp + H; P = P * Pp; }
            Pp = __shfl_up(P, 32); Hp = __shfl_up(H, 32); if (fq >= 2) { H = P * Hp + H; P = P * Pp; }
            Pe[t2] = __shfl_up(P, 16); He[t2] = __shfl_up(H, 16); if (fq == 0) { Pe[t2] = 1.f; He[t2] = 0.f; }
            if (fq == 3) { AS[wid * 32 + 16 * t2 + fr] = P; AS[256 + wid * 32 + 16 * t2 + fr] = H; } }
        __syncthreads();
#pragma unroll
        for (int t2 = 0; t2 < 2; ++t2) { float hin = hc[t2], mine = 0.f;
#pragma unroll
            for (int w = 0; w < 8; ++w) { const float P = AS[w * 32 + 16 * t2 + fr], H = AS[256 + w * 32 + 16 * t2 + fr]; if (w == wid) mine = hin; hin = P * hin + H; }
            hc[t2] = hin;
            const float cl = Pe[t2] * mine + He[t2];
#pragma unroll
            for (int rg = 0; rg < 4; ++rg) US[(16 * wid + 4 * fq + rg) * 32 + 16 * t2 + fr] = Hl[t2][rg] + Pl[t2][rg] * cl; }
        __syncthreads();
        { const int tok = tid >> 2, c8 = (tid & 3) * 8; const size_t rowi = (size_t)b * SEQ + t0 + tok;
          const LAS f32x4* hp = (const LAS f32x4*)(US + tok * 32 + c8); const f32x4 h0 = hp[0], h1 = hp[1];
          float y[8] = {bflo(yw.x), bfhi(yw.x), bflo(yw.y), bfhi(yw.y), bflo(yw.z), bfhi(yw.z), bflo(yw.w), bfhi(yw.w)};
          float hv[8] = {h0[0], h0[1], h0[2], h0[3], h1[0], h1[1], h1[2], h1[3]}; float o[8];
#pragma unroll
          for (int j = 0; j < 8; ++j) { const float z = 0.7978845608028654f * (y[j] + 0.044715f * y[j] * y[j] * y[j]); o[j] = hv[j] * y[j] * sigmoidf_(2.0f * z); }
          u32x4 w; w.x = pk2(o[0], o[1]); w.y = pk2(o[2], o[3]); w.z = pk2(o[4], o[5]); w.w = pk2(o[6], o[7]);
          *(u32x4*)(A.merged + rowi * D + n * 128 + 32 * qd + c8) = w; }
    }
    __syncthreads();
}
}

namespace dattn {
constexpr int KVB = 16384, BUFB = 32768, L_SCR = 65536, L_LUT = 65536 + 2048, QROWS = 128;
constexpr float THR = 8.0f;
__device__ __forceinline__ int crow(int r, int hi) { return (r & 3) + 8 * (r >> 2) + 4 * hi; }
__device__ __forceinline__ int swz(int row, int ch) { return 256 * row + 16 * (ch ^ (((row & 3) << 2) | ((row >> 2) & 3))); }
__device__ __forceinline__ s16x4 vtr(const LAS unsigned char* p) { typedef short v4 __attribute__((ext_vector_type(4))); return __builtin_bit_cast(s16x4, __builtin_amdgcn_ds_read_tr16_b64_v4i16((LAS v4*)p)); }
__device__ __forceinline__ unsigned cvtpk(float lo, float hi) { unsigned r; asm volatile("v_cvt_pk_bf16_f32 %0, %1, %2" : "=v"(r) : "v"(lo), "v"(hi)); return r; }
__device__ __forceinline__ void glds16(const void* gsrc, unsigned lds_dst) { unsigned keep;
    asm volatile("s_mov_b32 %0, m0\n\ts_mov_b32 m0, %2\n\ts_nop 0\n\tglobal_load_lds_dwordx4 %1, off\n\ts_mov_b32 m0, %0" : "=&s"(keep) : "v"(gsrc), "s"(lds_dst) : "memory"); }
__device__ __forceinline__ void issue_tile(const bf16* kvb, int t, LAS unsigned char* buf, int wid, int lane) {
#pragma unroll
    for (int i = 0; i < 2; ++i) { const int pc = wid + 8 * i, row = 4 * pc + (lane >> 4), lch = (lane & 15) ^ (((row & 3) << 2) | ((row >> 2) & 3));
        const bf16* g = kvb + (size_t)(64 * t + row) * IN_W + lch * 8;
        const unsigned dst = (unsigned)__builtin_amdgcn_readfirstlane((int)(unsigned)(size_t)(buf + pc * 1024));
        glds16(g + KOFF, dst); glds16(g + VOFF, dst + KVB); }
}
struct Args { const bf16* proj; bf16* merged; const float *rel_bias, *subln_g; float lam; };
__device__ __forceinline__ void unit(const Args& A, LAS unsigned char* lds, int b, int h, int qb) {
    const int tid = threadIdx.x, lane = tid & 63, wid = __builtin_amdgcn_readfirstlane(tid >> 6), r32 = lane & 31, hi = lane >> 5;
    const int rg = wid & 3, c = wid >> 2;
    const int q0 = qb * QROWS, qw = q0 + 32 * rg, qpos = qw + r32;
    const bf16* kvb = A.proj + (size_t)b * SEQ * IN_W + h * 128;
    LAS float* scr = (LAS float*)(lds + L_SCR) + wid * 64;
    LAS float* lut = (LAS float*)(lds + L_LUT);
    if (tid < 128) { int nn = tid; asm volatile("" : "+v"(nn));
        int bk = nn; if (nn >= 16) { bk = 16 + (int)(logf((float)nn * (1.0f / 16.0f)) / 2.0794415416798357f * 16.0f); bk = bk > 31 ? 31 : bk; }
        lut[nn] = A.rel_bias[bk * NH + h] * LOG2E; }
    const int NT = (q0 + QROWS) / 64;
    issue_tile(kvb, 0, lds, wid, lane);
    bf16x8 qf[4];
    { const bf16* qp = A.proj + ((size_t)b * SEQ + qpos) * IN_W + QOFF + h * 128 + c * 64 + hi * 8;
#pragma unroll
      for (int d0 = 0; d0 < 4; ++d0) qf[d0] = *(const bf16x8*)(qp + d0 * 16); }
    int koff[4], voff[2][4];
    { const int x = ((r32 & 3) << 2) | ((r32 >> 2) & 3);
#pragma unroll
      for (int d0 = 0; d0 < 4; ++d0) koff[d0] = 256 * r32 + 16 * ((c * 8 + 2 * d0 + hi) ^ x);
      const int gi = lane & 15, q = gi >> 2, p = gi & 3, chh = (lane >> 4) & 1;
#pragma unroll
      for (int hh = 0; hh < 2; ++hh)
#pragma unroll
          for (int dt = 0; dt < 4; ++dt) voff[hh][dt] = KVB + swz(4 * hi + 8 * hh + q, 4 * dt + 2 * chh + (p >> 1)) + 8 * (p & 1); }
    f32x16 O[4];
#pragma unroll
    for (int dt = 0; dt < 4; ++dt)
#pragma unroll
        for (int r = 0; r < 16; ++r) O[dt][r] = 0.f;
    float m = 0.f, l = 0.f;
    asm volatile("s_waitcnt vmcnt(0)" ::: "memory");
    asm volatile("" : "+v"(qf[0]), "+v"(qf[1]), "+v"(qf[2]), "+v"(qf[3]));
    __syncthreads();
    const float c31 = lut[127];
    f32x16 cinit;
#pragma unroll
    for (int r = 0; r < 16; ++r) cinit[r] = c31;
    asm volatile("" : "+v"(cinit));
    for (int t = 0; t < NT; ++t) {
        const LAS unsigned char* buf = lds + (t & 1) * BUFB;
        if (t + 1 < NT) issue_tile(kvb, t + 1, lds + ((t + 1) & 1) * BUFB, wid, lane);
        if (64 * t <= qw + 31) {
            const bool near = (64 * t + 63 + 113 > qw);
            f32x16 S[2];
#pragma unroll
            for (int nt = 0; nt < 2; ++nt)
#pragma unroll
                for (int d0 = 0; d0 < 4; ++d0) { const bf16x8 kf = *(const LAS bf16x8*)(buf + nt * 8192 + koff[d0]);
                    S[nt] = __builtin_amdgcn_mfma_f32_32x32x16_bf16(kf, qf[d0], d0 == 0 ? cinit : S[nt], 0, 0, 0); }
            if (near) {
                const int dbase = qpos - 64 * t - 4 * hi;
                float bvv[2][16];
#pragma unroll
                for (int nt = 0; nt < 2; ++nt)
#pragma unroll
                    for (int r = 0; r < 16; ++r) { const int dist = dbase - ((r & 3) + 8 * (r >> 2) + 32 * nt); bvv[nt][r] = lut[dist < 0 ? 0 : (dist > 127 ? 127 : dist)] - c31; }
#pragma unroll
                for (int nt = 0; nt < 2; ++nt)
                    asm volatile("" : "+v"(bvv[nt][0]), "+v"(bvv[nt][1]), "+v"(bvv[nt][2]), "+v"(bvv[nt][3]), "+v"(bvv[nt][4]), "+v"(bvv[nt][5]), "+v"(bvv[nt][6]), "+v"(bvv[nt][7]),
                                      "+v"(bvv[nt][8]), "+v"(bvv[nt][9]), "+v"(bvv[nt][10]), "+v"(bvv[nt][11]), "+v"(bvv[nt][12]), "+v"(bvv[nt][13]), "+v"(bvv[nt][14]), "+v"(bvv[nt][15]));
#pragma unroll
                for (int nt = 0; nt < 2; ++nt)
#pragma unroll
                    for (int r = 0; r < 16; ++r) { const int dist = dbase - ((r & 3) + 8 * (r >> 2) + 32 * nt); S[nt][r] = dist >= 0 ? S[nt][r] + bvv[nt][r] : -INFINITY; }
            }
            float rm = S[0][0];
#pragma unroll
            for (int r = 1; r < 16; ++r) rm = fmaxf(rm, S[0][r]);
#pragma unroll
            for (int r = 0; r < 16; ++r) rm = fmaxf(rm, S[1][r]);
            { const auto rr = __builtin_amdgcn_permlane32_swap(__float_as_uint(rm), __float_as_uint(rm), false, false); rm = fmaxf(__uint_as_float(rr[0]), __uint_as_float(rr[1])); }
            if (t == 0 || __any(rm > THR)) {
                const float dl = (t == 0) ? rm : fmaxf(rm, 0.f); m += dl;
#pragma unroll
                for (int nt = 0; nt < 2; ++nt)
#pragma unroll
                    for (int r = 0; r < 16; ++r) S[nt][r] -= dl;
                const float f = __builtin_amdgcn_exp2f(-dl); l *= f;
#pragma unroll
                for (int r = 0; r < 16; ++r) cinit[r] = c31 - m;
                asm volatile("" : "+v"(cinit));
                if (hi == 0) scr[r32] = f;
                asm volatile("s_waitcnt lgkmcnt(0)" ::: "memory");
#pragma unroll
                for (int r = 0; r < 16; ++r) { const float fr_ = scr[crow(r, hi)];
#pragma unroll
                    for (int dt = 0; dt < 4; ++dt) O[dt][r] *= fr_; }
                asm volatile("s_waitcnt lgkmcnt(0)" ::: "memory");
            }
            float sacc = 0.f;
#pragma unroll
            for (int nt = 0; nt < 2; ++nt)
#pragma unroll
                for (int r = 0; r < 16; ++r) { S[nt][r] = __builtin_amdgcn_exp2f(S[nt][r]); sacc += S[nt][r]; }
            l += sacc;
            bf16x8 pw[4];
#pragma unroll
            for (int s = 0; s < 4; ++s) { const int nt = s >> 1, r0 = 8 * (s & 1); u32x4 w;
                w.x = cvtpk(S[nt][r0], S[nt][r0 + 1]); w.y = cvtpk(S[nt][r0 + 2], S[nt][r0 + 3]); w.z = cvtpk(S[nt][r0 + 4], S[nt][r0 + 5]); w.w = cvtpk(S[nt][r0 + 6], S[nt][r0 + 7]);
                pw[s] = __builtin_bit_cast(bf16x8, w); }
            s16x4 vl[2][4], vh[2][4];
#pragma unroll
            for (int dt = 0; dt < 4; ++dt) { vl[0][dt] = vtr(buf + voff[0][dt]); vh[0][dt] = vtr(buf + voff[1][dt]); }
#pragma unroll
            for (int s = 0; s < 4; ++s) {
                if (s < 3) {
#pragma unroll
                    for (int dt = 0; dt < 4; ++dt) { vl[(s + 1) & 1][dt] = vtr(buf + (s + 1) * 4096 + voff[0][dt]); vh[(s + 1) & 1][dt] = vtr(buf + (s + 1) * 4096 + voff[1][dt]); } }
#pragma unroll
                for (int dt = 0; dt < 4; ++dt) { const s16x4 lo = vl[s & 1][dt], hi4 = vh[s & 1][dt];
                    const bf16x8 vf = (bf16x8){lo[0], lo[1], lo[2], lo[3], hi4[0], hi4[1], hi4[2], hi4[3]};
                    O[dt] = __builtin_amdgcn_mfma_f32_32x32x16_bf16(pw[s], vf, O[dt], 0, 0, 0); } }
        }
        asm volatile("s_waitcnt vmcnt(0)" ::: "memory"); __syncthreads();
    }
    l += __shfl_xor(l, 32);
    if (hi == 0) scr[r32] = (c == 0 ? 1.0f : A.lam) / l;
    asm volatile("s_waitcnt lgkmcnt(0)" ::: "memory");
#pragma unroll
    for (int r = 0; r < 16; ++r) { const float i0 = scr[crow(r, hi)];
#pragma unroll
        for (int dt = 0; dt < 4; ++dt) O[dt][r] *= i0; }
    int ln_ = lane; asm volatile("" : "+v"(ln_));
    LAS float* xch = (LAS float*)lds + rg * 4096 + ln_;
    if (c == 1) {
#pragma unroll
        for (int dt = 0; dt < 4; ++dt)
#pragma unroll
            for (int r = 0; r < 16; ++r) xch[(dt * 16 + r) * 64] = O[dt][r];
    }
    __syncthreads();
    if (c == 0) {
        float ss[16];
#pragma unroll
        for (int r = 0; r < 16; ++r) { float s = 0.f;
#pragma unroll
            for (int dt = 0; dt < 4; ++dt) { const float o = O[dt][r] - xch[(dt * 16 + r) * 64]; O[dt][r] = o; s += o * o; }
            ss[r] = s; }
#pragma unroll
        for (int r = 0; r < 16; ++r) { float s = ss[r]; s += __shfl_xor(s, 1); s += __shfl_xor(s, 2); s += __shfl_xor(s, 4); s += __shfl_xor(s, 8); s += __shfl_xor(s, 16);
            ss[r] = (1.0f - LAM_INIT) / sqrtf(s * (1.0f / 128.0f) + LN_EPS); }
#pragma unroll
        for (int dt = 0; dt < 4; ++dt) { const float g = A.subln_g[32 * dt + r32];
#pragma unroll
            for (int r = 0; r < 16; ++r) { const size_t rowi = (size_t)b * SEQ + qw + crow(r, hi);
                A.merged[rowi * D + LRU_W + h * 128 + 32 * dt + r32] = (bf16)f2bf(O[dt][r] * ss[r] * g); } }
    }
    __syncthreads();
}
}

#define RLX_AGENT __ATOMIC_RELAXED, __HIP_MEMORY_SCOPE_AGENT
#define XB_TMO      128
#define XB_XCNT(j)  (256  + 64 * (j))
#define XB_XSUB(j)  (1280 + 64 * (j))
#define XB_XGEN(j)  (2304 + 64 * (j))
#define XB_TOP      3328
#define XB_TOPGEN   3392
#define XCD_BAR_WORDS 3456
#define XB_SPIN_CAP (1u << 18)

__device__ __forceinline__ unsigned xb_ld(unsigned* p)              { return __hip_atomic_load(p, __ATOMIC_RELAXED, __HIP_MEMORY_SCOPE_AGENT); }
__device__ __forceinline__ unsigned xb_add(unsigned* p, unsigned v) { return __hip_atomic_fetch_add(p, v, __ATOMIC_RELAXED, __HIP_MEMORY_SCOPE_AGENT); }
__device__ __forceinline__ unsigned xb_xcc_id() { return (unsigned)__builtin_amdgcn_s_getreg((3 << 11) | 20) & 0xFu; }
#define XB_SPIN(cond, bar) do { unsigned _sp = 0; while (cond) { __builtin_amdgcn_s_sleep(1); \
    if ((++_sp & 255u) == 0u) { if (xb_ld(&(bar)[XB_TMO])) break; if (_sp > XB_SPIN_CAP) { atomicAdd(&(bar)[XB_TMO], 1u); break; } } } } while (0)

struct XcdBarrier {
    unsigned* bar; unsigned x;
    volatile LAS unsigned* st;
};

__device__ __forceinline__ XcdBarrier xcd_barrier_post(unsigned* bar, volatile LAS unsigned* st) {
    XcdBarrier b; b.bar = bar; b.x = xb_xcc_id(); b.st = st;
    if (threadIdx.x == 0) (void)xb_add(&bar[XB_XCNT(b.x)], 1u);
    return b;
}
__device__ __forceinline__ void xcd_barrier_complete(unsigned* bar, unsigned x, unsigned& nloc, unsigned& nx) {
    const unsigned G = gridDim.x * gridDim.y * gridDim.z;
    unsigned sum, cnt, mine, sp = 0u;
    for (;;) {
        sum = 0u; cnt = 0u; mine = 0u;
#pragma unroll
        for (unsigned j = 0; j < 16; ++j) { const unsigned c = xb_ld(&bar[XB_XCNT(j)]); sum += c; cnt += (c > 0u) ? 1u : 0u; mine = (j == x) ? c : mine; }
        if (sum == G) break;
        __builtin_amdgcn_s_sleep(1);
        if ((++sp & 255u) == 0u) { if (xb_ld(&bar[XB_TMO])) break; if (sp > XB_SPIN_CAP) { atomicAdd(&bar[XB_TMO], 1u); break; } }
    }
    nloc = mine > 0u ? mine : 1u; nx = cnt > 0u ? cnt : 1u;
}

__device__ __forceinline__ void xcd_barrier(const XcdBarrier& b) {
    asm volatile("s_waitcnt vmcnt(0)" ::: "memory");
    __syncthreads();
    if (threadIdx.x == 0) {
        unsigned* bar = b.bar;
        __builtin_amdgcn_s_waitcnt(0);
        unsigned nloc = b.st[0], nx = b.st[1];
        if (nloc == 0u) { xcd_barrier_complete(bar, b.x, nloc, nx); b.st[0] = nloc; b.st[1] = nx; }
        const unsigned old = xb_add(&bar[XB_XSUB(b.x)], 1u);
        const unsigned gen = old / nloc;
        if (old + 1u == (gen + 1u) * nloc) {
            __builtin_amdgcn_fence(__ATOMIC_RELEASE, "agent");
            asm volatile("s_waitcnt vmcnt(0)" ::: "memory");
            const unsigned og = xb_add(&bar[XB_TOP], 1u);
            const unsigned tg = og / nx;
            if (og + 1u == (tg + 1u) * nx) xb_add(&bar[XB_TOPGEN], 1u);
            else XB_SPIN(xb_ld(&bar[XB_TOPGEN]) == tg, bar);
            __builtin_amdgcn_fence(__ATOMIC_ACQUIRE, "agent");
            xb_add(&bar[XB_XGEN(b.x)], 1u);
            asm volatile("s_waitcnt vmcnt(0)" ::: "memory");
        } else {
            XB_SPIN(xb_ld(&bar[XB_XGEN(b.x)]) == gen, bar);
            __builtin_amdgcn_fence(__ATOMIC_ACQUIRE, "agent");
            asm volatile("s_waitcnt vmcnt(0)" ::: "memory");
        }
    }
    __syncthreads();
}

constexpr int NPH = 10;
struct Args { const float* in[29]; float* out; unsigned char* ws; int ph_lo, ph_hi; };
__global__ void __launch_bounds__(NWAVES * 64, 2) hymba_fwd(Args args) {
    extern __shared__ __attribute__((aligned(16))) unsigned char lds_raw[];
    LAS unsigned char* lds = (LAS unsigned char*)lds_raw;
    cg::grid_group grid = cg::this_grid();
    const int tid = threadIdx.x, lane = tid & 63, wave = __builtin_amdgcn_readfirstlane(tid >> 6);
    const int G = gridDim.x, bx = blockIdx.x;
    const int gw = bx * NWAVES + wave, NGW = G * NWAVES;
    unsigned char* ws = args.ws;
    typedef __attribute__((address_space(4))) const unsigned long long kconst_t;
    kconst_t* karg = (kconst_t*)__builtin_amdgcn_kernarg_segment_ptr();
#define INP(k) ((const float*)karg[k])
    bf16 *Win = (bf16*)(ws + WS_WIN), *Wout = (bf16*)(ws + WS_WOUT), *Wgu = (bf16*)(ws + WS_WGU), *Wdn = (bf16*)(ws + WS_WDN), *Wpg = (bf16*)(ws + WS_WPG), *Wpp = (bf16*)(ws + WS_WPP), *Wlru = (bf16*)(ws + WS_WLRU);
    bf16 *PB = (bf16*)(ws + WS_PB), *R = (bf16*)(ws + WS_R), *E = (bf16*)(ws + WS_E), *MG = (bf16*)(ws + WS_MG), *XB = (bf16*)(ws + WS_Y);
    bf16* Y = (bf16*)(ws + WS_Y + 128 * MiB);
    const int lo = args.ph_lo, hi = args.ph_hi;
    volatile LAS unsigned* MISC = (volatile LAS unsigned*)(lds + 131072 + 1024);
    if (tid < 16) MISC[tid] = 0u;
    __syncthreads();
    XcdBarrier xbar = xcd_barrier_post((unsigned*)(ws + WS_CTL), MISC + 8);
#define IN(k) (lo <= (k) && (k) < hi)
#define SEAM(k) do { if (IN(k) && IN((k) + 1)) xcd_barrier(xbar); } while (0)
    if (lo > hi) grid.sync();

    if (IN(0)) {
        P0Args A{INP(0), INP(1), INP(2), INP(16), INP(19), INP(20), INP(21), INP(24), INP(26), INP(5), INP(7), Win, Wout, Wgu, Wdn, Wpg, Wpp, Wlru, XB, PB};
        p0_prologue(A, lds, gw, NGW, wave, lane);
    }
    SEAM(0);
    if (IN(1)) {
        { pg8::Gemm g{XB, Win, M, IN_W, D}; pg8::StaticOrder S; S.init(M, IN_W, G, bx); pg8::EpiBf16 Ep{R, IN_W};
          pg8::gemm_phase<pg8::EpiBf16, pg8::StaticOrder, true, true>(lds, g, S, Ep); }
        { pg8::Gemm g{PB, Wpp, M, D, PLE}; pg8::StaticOrder S; S.init(M, D, G, bx); pg8::EpiBf16 Ep{E, D};
          pg8::gemm_phase<pg8::EpiBf16, pg8::StaticOrder, true, true>(lds, g, S, Ep); }
    }
    SEAM(1);
    if (IN(2)) {
        { lru::Args A{R, Wlru, INP(3), INP(4), INP(6), INP(8), INP(9), MG};
          for (int u = bx; u < BATCH * 8 * 4; u += G) lru::unit(A, lds, u); }
        { float d1 = 0.f, d2 = 0.f; { const float a1 = INP(10)[lane] * INP(11)[lane], a2 = INP(12)[lane] * INP(13)[lane]; d1 = wave_sum(a1); d2 = wave_sum(a2); }
          const float lam = __int_as_float(__builtin_amdgcn_readfirstlane(__float_as_int(expf(d1) - expf(d2) + LAM_INIT)));
          dattn::Args A{R, MG, INP(15), INP(14), lam};
          if (G == 256) {
              const int x = bx & 7, k = bx >> 3, s = k & 15;
              for (int j = 0; j < 8; ++j) { const int bh = j * 16 + x * 2 + (k >> 4); dattn::unit(A, lds, bh >> 3, bh & 7, (j & 1) ? s : 15 - s); }
          } else {
              for (int it = bx; it < BATCH * NH * 16; it += G) { const int bh = it >> 4, s = it & 15; dattn::unit(A, lds, bh >> 3, bh & 7, ((it / G) & 1) ? s : 15 - s); }
          } }
    }
    SEAM(2);
    if (IN(3)) {
        pg8::Gemm g{MG, Wout, M, D, D}; pg8::StaticOrder S; S.init(M, D, G, bx); pg8::EpiRes Ep{INP(0), Y, D, ALPHA};
        pg8::gemm_phase<pg8::EpiRes, pg8::StaticOrder, true, true>(lds, g, S, Ep);
    }
    SEAM(3);
    if (IN(4)) ln_rows(Y, INP(17), INP(18), nullptr, MG, gw, NGW, lane);
    SEAM(4);
    if (IN(5)) {
        pg8::Gemm g{MG, Wgu, M, 2 * FFN, D}; pg8::StaticOrder S; S.init(M, 2 * FFN, G, bx); pg8::EpiSwiglu Ep{R, FFN};
        pg8::gemm_phase<pg8::EpiSwiglu, pg8::StaticOrder, true, true>(lds, g, S, Ep);
    }
    SEAM(5);
    if (IN(6)) {
        pg8::Gemm g{R, Wdn, M, D, FFN}; pg8::StaticOrder S; S.init(M, D, G, bx); pg8::EpiResB Ep{MG, Y, ALPHA};
        pg8::gemm_phase<pg8::EpiResB, pg8::StaticOrder, true, true>(lds, g, S, Ep);
    }
    SEAM(6);
    if (IN(7)) ln_rows(Y, INP(22), INP(23), nullptr, MG, gw, NGW, lane);
    SEAM(7);
    if (IN(8)) {
        pg8::Gemm g{MG, Wpg, M, D, D}; pg8::StaticOrder S; S.init(M, D, G, bx); pg8::EpiPleB Ep{MG, E, INP(25), Y, ALPHA};
        pg8::gemm_phase<pg8::EpiPleB, pg8::StaticOrder, true, true>(lds, g, S, Ep);
    }
    SEAM(8);
    if (IN(9)) ln_rows(Y, INP(27), INP(28), args.out, nullptr, gw, NGW, lane);
#undef IN
#undef SEAM
}

#ifndef MK_PER_PHASE
#define MK_PER_PHASE 0
#endif
extern "C" void kernel_launch(void* const* d_in, const int* in_sizes, int n_in, void* d_out, int out_size, void* d_ws, size_t ws_size, hipStream_t stream) {
    static int grid = 0;
    if (grid == 0) {
        if (n_in != 29 || out_size != M * D || ws_size < WS_END) { fprintf(stderr, "kernel_launch: unexpected shapes (n_in %d out %d ws %zu)\n", n_in, out_size, ws_size); grid = -1; return; }
        int dev = 0, cus = 0, per_cu = 0;
        hipGetDevice(&dev); hipDeviceGetAttribute(&cus, hipDeviceAttributeMultiprocessorCount, dev);
        if (hipFuncSetAttribute((const void*)hymba_fwd, hipFuncAttributeMaxDynamicSharedMemorySize, LDS_BYTES) != hipSuccess) { fprintf(stderr, "kernel_launch: hipFuncSetAttribute failed\n"); grid = -1; return; }
        hipOccupancyMaxActiveBlocksPerMultiprocessor(&per_cu, (const void*)hymba_fwd, NWAVES * 64, LDS_BYTES);
        (void)hipGetLastError();
        if (per_cu < 1) fprintf(stderr, "kernel_launch: occupancy query says %d blocks per CU\n", per_cu);
        grid = cus > 0 ? cus : 256;
    }
    if (grid < 0) return;
    Args a{};
    for (int i = 0; i < 29; ++i) a.in[i] = (const float*)d_in[i];
    a.out = (float*)d_out; a.ws = (unsigned char*)d_ws;
#if MK_PER_PHASE
    for (int ph = 0; ph < NPH; ++ph) { a.ph_lo = ph; a.ph_hi = ph + 1; hipLaunchKernelGGL(hymba_fwd, dim3(grid), dim3(NWAVES * 64), LDS_BYTES, stream, a); }
#else
    a.ph_lo = 0; a.ph_hi = NPH;
    if (hipMemsetAsync((char*)d_ws + WS_CTL, 0, CTL_BYTES, stream) != hipSuccess) { fprintf(stderr, "kernel_launch: memset failed\n"); return; }
    void* kargs[] = {&a};
    hipError_t e = hipLaunchCooperativeKernel((const void*)hymba_fwd, dim3(grid), dim3(NWAVES * 64), kargs, LDS_BYTES, stream);
    if (e != hipSuccess) fprintf(stderr, "kernel_launch: cooperative launch failed: %s (grid %d)\n", hipGetErrorString(e), grid);
#endif
}
```
